# Optimizing an MI355X kernel written in HIP

```python
import jax, jax.numpy as jnp
from jax import lax
import numpy as np

D_MODEL = 1024
BATCH = 2
SEQ = 8192
DEPTH = 1

D_MIX = D_MODEL
RG_WIDTH = D_MIX // 2
RG_BLOCKS = 8
RG_BLOCK = RG_WIDTH // RG_BLOCKS
RG_C = 8.0
CONV_W = 4
GDN_HEADS = 4
GDN_DK = 128
GDN_DV = 128
GDN_QK = GDN_HEADS * GDN_DK
GDN_VW = GDN_HEADS * GDN_DV
CHUNK = 64
D_FF = 2816
N_DIR = 2
EPS = 1e-6

OFF_RG_X = 0
OFF_RG_G = OFF_RG_X + RG_WIDTH
OFF_QKV = OFF_RG_G + RG_WIDTH
OFF_Z = OFF_QKV + 2 * GDN_QK + GDN_VW
OFF_BETA = OFF_Z + GDN_VW
OFF_ALPHA = OFF_BETA + N_DIR * GDN_HEADS
D_IN_PROJ = OFF_ALPHA + N_DIR * GDN_HEADS

kernel_name = "hymba_style_rglru_gdn_macaron_encoder"


def rmsnorm(x, g):
    xf = x.astype(jnp.float32)
    y = xf * lax.rsqrt(jnp.mean(xf * xf, axis=-1, keepdims=True) + EPS)
    return (y * g.astype(jnp.float32)).astype(x.dtype)


def l2norm(t):
    return t * lax.rsqrt(jnp.sum(t * t, axis=-1, keepdims=True) + EPS)


def centred_dwconv(x, w):
    left = CONV_W // 2
    return lax.conv_general_dilated(
        x, w[:, None, :].astype(x.dtype), window_strides=(1,),
        padding=[(left, CONV_W - 1 - left)],
        dimension_numbers=("NWC", "WIO", "NWC"),
        feature_group_count=x.shape[-1])


def swiglu_ffn(x, g, w_gate, w_up, w_down):
    h = rmsnorm(x, g)
    return (jax.nn.silu(h @ w_gate) * (h @ w_up)) @ w_down


def linear_scan(a, b, reverse):
    def combine(l, r):
        return (l[0] * r[0], r[0] * l[1] + r[1])
    _, h = lax.associative_scan(combine, (a, b), reverse=reverse, axis=1)
    return h


def rg_lru_bidir(xc, wa, ba, wx, bx, lam):
    B, S, _ = xc.shape
    xb = xc.reshape(B, S, RG_BLOCKS, RG_BLOCK)
    r = jax.nn.sigmoid(jnp.einsum("bsni,dnij->dbsnj", xb, wa.astype(jnp.float32)).reshape(N_DIR, B, S, RG_WIDTH)
                       + ba.astype(jnp.float32)[:, None, None, :])
    i = jax.nn.sigmoid(jnp.einsum("bsni,dnij->dbsnj", xb, wx.astype(jnp.float32)).reshape(N_DIR, B, S, RG_WIDTH)
                       + bx.astype(jnp.float32)[:, None, None, :])
    log_a = -RG_C * r * jax.nn.softplus(-lam.astype(jnp.float32))[:, None, None, :]
    a = jnp.exp(log_a)
    b = jnp.sqrt(-jnp.expm1(2.0 * log_a)) * (i * xc[None])
    h_f = linear_scan(a[0], b[0], reverse=False)
    h_b = linear_scan(a[1], b[1], reverse=True)
    return h_f + h_b


def gdn_chunked(q, k, v, beta, g):
    B, S, H, DK = q.shape
    DV = v.shape[-1]
    N = S // CHUNK

    def chunks(t):
        t = t.reshape((B, N, CHUNK, H) + t.shape[3:])
        return jnp.moveaxis(t, 3, 1)

    q, k, v, beta, g = chunks(q), chunks(k), chunks(v), chunks(beta), chunks(g)
    g_cum = jnp.cumsum(g, axis=-1)
    idx = jnp.arange(CHUNK)
    incl = idx[:, None] >= idx[None, :]
    strict = idx[:, None] > idx[None, :]
    decay = jnp.exp(jnp.where(incl, g_cum[..., :, None] - g_cum[..., None, :], -jnp.inf))
    k_beta = k * beta[..., None]
    v_beta = v * beta[..., None]
    L = jnp.where(strict, jnp.einsum("bhnik,bhnjk->bhnij", k_beta, k) * decay, 0.0)
    eye = jnp.broadcast_to(jnp.eye(CHUNK, dtype=q.dtype), L.shape)
    T = lax.linalg.triangular_solve(L, eye, left_side=True, lower=True, unit_diagonal=True)
    u = jnp.einsum("bhnij,bhnjv->bhniv", T, v_beta)
    w = jnp.einsum("bhnij,bhnjk->bhnik", T, k_beta * jnp.exp(g_cum)[..., None])
    attn = jnp.einsum("bhnik,bhnjk->bhnij", q, k) * decay
    g_last = g_cum[..., -1:]
    q_dec = q * jnp.exp(g_cum)[..., None]
    k_dec = k * jnp.exp(g_last - g_cum)[..., None]
    c_decay = jnp.exp(g_last[..., 0])

    xs = tuple(jnp.moveaxis(t, 2, 0) for t in (w, u, q_dec, k_dec, attn, c_decay))

    def step(state, inp):
        w_n, u_n, qd_n, kd_n, a_n, cd_n = inp
        v_new = u_n - jnp.einsum("bhck,bhkv->bhcv", w_n, state)
        o_n = jnp.einsum("bhck,bhkv->bhcv", qd_n, state) + jnp.einsum("bhij,bhjv->bhiv", a_n, v_new)
        state = state * cd_n[..., None, None] + jnp.einsum("bhck,bhcv->bhkv", kd_n, v_new)
        return state, o_n

    s0 = jnp.zeros((B, H, DK, DV), q.dtype)
    _, o = lax.scan(step, s0, xs)
    return jnp.transpose(o, (1, 0, 3, 2, 4)).reshape(B, S, H, DV)


def hybrid_mixer(h, w_in, w_out, rg_conv_w, rg_conv_b, rg_gate_a_w, rg_gate_a_b,
                 rg_gate_x_w, rg_gate_x_b, rg_lambda, gdn_conv_w, gdn_a_log, gdn_dt_bias, gdn_norm):
    B, S, _ = h.shape
    f32 = jnp.float32
    p = h @ w_in
    x_rg = p[..., OFF_RG_X:OFF_RG_G]
    gate_rg = p[..., OFF_RG_G:OFF_QKV]
    qkv = p[..., OFF_QKV:OFF_Z]
    z = p[..., OFF_Z:OFF_BETA]
    beta_raw = p[..., OFF_BETA:OFF_ALPHA].reshape(B, S, N_DIR, GDN_HEADS)
    alpha_raw = p[..., OFF_ALPHA:D_IN_PROJ].reshape(B, S, N_DIR, GDN_HEADS)

    xc = (centred_dwconv(x_rg, rg_conv_w) + rg_conv_b).astype(f32)
    hr = rg_lru_bidir(xc, rg_gate_a_w, rg_gate_a_b, rg_gate_x_w, rg_gate_x_b, rg_lambda)
    y_rg = (hr * jax.nn.gelu(gate_rg.astype(f32))).astype(h.dtype)

    qkv = jax.nn.silu(centred_dwconv(qkv, gdn_conv_w)).astype(f32)
    q = l2norm(qkv[..., :GDN_QK].reshape(B, S, GDN_HEADS, GDN_DK)) * (GDN_DK ** -0.5)
    k = l2norm(qkv[..., GDN_QK:2 * GDN_QK].reshape(B, S, GDN_HEADS, GDN_DK))
    v = qkv[..., 2 * GDN_QK:].reshape(B, S, GDN_HEADS, GDN_DV)
    beta = jax.nn.sigmoid(beta_raw.astype(f32))
    g = -jnp.exp(gdn_a_log.astype(f32)) * jax.nn.softplus(alpha_raw.astype(f32) + gdn_dt_bias.astype(f32))
    flip = lambda t: jnp.flip(t, axis=1)
    o_f = gdn_chunked(q, k, v, beta[:, :, 0], g[:, :, 0])
    o_b = flip(gdn_chunked(flip(q), flip(k), flip(v), flip(beta[:, :, 1]), flip(g[:, :, 1])))
    o = rmsnorm(o_f + o_b, gdn_norm) * jax.nn.silu(z.astype(f32).reshape(B, S, GDN_HEADS, GDN_DV))
    y_gdn = o.reshape(B, S, GDN_VW).astype(h.dtype)

    return jnp.concatenate([y_rg, y_gdn], axis=-1) @ w_out


def setup_inputs(seed: int = 0) -> dict:
    key = jax.random.key(seed)
    ks = iter(jax.random.split(key, 32))
    nrm = lambda shape, scale: jax.random.normal(next(ks), shape, jnp.float32) * scale
    gain = lambda shape: 1.0 + nrm(shape, 0.01)
    L = DEPTH
    a_c = jax.random.uniform(next(ks), (L, N_DIR, RG_WIDTH), jnp.float32, 0.9, 0.999)
    s = a_c ** (1.0 / RG_C)
    rg_lambda = jnp.log(s) - jnp.log1p(-s)
    gdn_a_log = jnp.log(jax.random.uniform(next(ks), (L, N_DIR, GDN_HEADS), jnp.float32, 1.0, 16.0))
    dt = jnp.exp(jax.random.uniform(next(ks), (L, N_DIR, GDN_HEADS), jnp.float32, np.log(1e-3), np.log(1e-1)))
    gdn_dt_bias = dt + jnp.log(-jnp.expm1(-dt))
    return {
        "x": nrm((BATCH, SEQ, D_MODEL), 1.0),
        "ffn1_norm": gain((L, D_MODEL)),
        "ffn1_w_gate": nrm((L, D_MODEL, D_FF), D_MODEL ** -0.5),
        "ffn1_w_up": nrm((L, D_MODEL, D_FF), D_MODEL ** -0.5),
        "ffn1_w_down": nrm((L, D_FF, D_MODEL), D_FF ** -0.5),
        "mix_norm": gain((L, D_MODEL)),
        "w_in": nrm((L, D_MODEL, D_IN_PROJ), D_MODEL ** -0.5),
        "w_out": nrm((L, D_MIX, D_MODEL), D_MIX ** -0.5),
        "rg_conv_w": nrm((L, CONV_W, RG_WIDTH), CONV_W ** -0.5),
        "rg_conv_b": nrm((L, RG_WIDTH), 0.01),
        "rg_gate_a_w": nrm((L, N_DIR, RG_BLOCKS, RG_BLOCK, RG_BLOCK), RG_BLOCK ** -0.5),
        "rg_gate_a_b": nrm((L, N_DIR, RG_WIDTH), 0.01),
        "rg_gate_x_w": nrm((L, N_DIR, RG_BLOCKS, RG_BLOCK, RG_BLOCK), RG_BLOCK ** -0.5),
        "rg_gate_x_b": nrm((L, N_DIR, RG_WIDTH), 0.01),
        "rg_lambda": rg_lambda,
        "gdn_conv_w": nrm((L, CONV_W, 2 * GDN_QK + GDN_VW), CONV_W ** -0.5),
        "gdn_a_log": gdn_a_log,
        "gdn_dt_bias": gdn_dt_bias,
        "gdn_norm": gain((L, GDN_DV)),
        "ffn2_norm": gain((L, D_MODEL)),
        "ffn2_w_gate": nrm((L, D_MODEL, D_FF), D_MODEL ** -0.5),
        "ffn2_w_up": nrm((L, D_MODEL, D_FF), D_MODEL ** -0.5),
        "ffn2_w_down": nrm((L, D_FF, D_MODEL), D_FF ** -0.5),
        "final_norm": gain((D_MODEL,)),
    }


def reference(x, ffn1_norm, ffn1_w_gate, ffn1_w_up, ffn1_w_down, mix_norm, w_in, w_out,
              rg_conv_w, rg_conv_b, rg_gate_a_w, rg_gate_a_b, rg_gate_x_w, rg_gate_x_b, rg_lambda,
              gdn_conv_w, gdn_a_log, gdn_dt_bias, gdn_norm,
              ffn2_norm, ffn2_w_gate, ffn2_w_up, ffn2_w_down, final_norm):
    for l in range(DEPTH):
        x = x + 0.5 * swiglu_ffn(x, ffn1_norm[l], ffn1_w_gate[l], ffn1_w_up[l], ffn1_w_down[l])
        x = x + hybrid_mixer(rmsnorm(x, mix_norm[l]), w_in[l], w_out[l],
                             rg_conv_w[l], rg_conv_b[l], rg_gate_a_w[l], rg_gate_a_b[l],
                             rg_gate_x_w[l], rg_gate_x_b[l], rg_lambda[l],
                             gdn_conv_w[l], gdn_a_log[l], gdn_dt_bias[l], gdn_norm[l])
        x = x + 0.5 * swiglu_ffn(x, ffn2_norm[l], ffn2_w_gate[l], ffn2_w_up[l], ffn2_w_down[l])
    return rmsnorm(x, final_norm)
```

```cpp
#include <hip/hip_runtime.h>
#include <stdint.h>
#include <cstdio>

typedef unsigned short bf16_t;
typedef short bf16x8 __attribute__((ext_vector_type(8)));
typedef float f32x4 __attribute__((ext_vector_type(4)));

constexpr int D = 1024, BATCH = 2, SEQ = 8192, M = BATCH * SEQ, DFF = 2816, DIN = 3088, NP = 3072;
constexpr float EPS = 1e-6f;
constexpr size_t MiB = 1u << 20;
constexpr size_t WS_BA = 1 * MiB;
constexpr size_t WS_XN = 2 * MiB;
constexpr size_t WS_P = 34 * MiB;
constexpr size_t WS_HR = 130 * MiB;
constexpr size_t WS_OF = 162 * MiB;
constexpr size_t WS_OB = 194 * MiB;

__device__ __forceinline__ unsigned f2bf(float f) { unsigned u = __float_as_uint(f); return (u + 0x7fffu + ((u >> 16) & 1u)) >> 16; }
__device__ __forceinline__ float bf2f(bf16_t b) { return __uint_as_float((unsigned)b << 16); }
__device__ __forceinline__ float wave_sum(float v) {
#pragma unroll
    for (int o = 1; o < 64; o <<= 1) v += __shfl_xor(v, o);
    return v;
}
__device__ __forceinline__ float sigmoidf_(float x) { return 1.f / (1.f + expf(-x)); }
__device__ __forceinline__ float siluf_(float x) { return x / (1.f + expf(-x)); }
__device__ __forceinline__ float gelu_tanh(float x) { return 0.5f * x * (1.f + tanhf(0.7978845608028654f * (x + 0.044715f * x * x * x))); }

template <bool OUT_F32>
__global__ void __launch_bounds__(256) rmsnorm_rows(const float* x, const float* g, void* out) {
    const int lane = threadIdx.x & 63, row = blockIdx.x * 4 + (threadIdx.x >> 6);
    const f32x4* xr = (const f32x4*)(x + (size_t)row * D) + lane;
    f32x4 v[4]; float s = 0.f;
#pragma unroll
    for (int j = 0; j < 4; ++j) { v[j] = xr[64 * j]; s += v[j].x * v[j].x + v[j].y * v[j].y + v[j].z * v[j].z + v[j].w * v[j].w; }
    const float rstd = rsqrtf(wave_sum(s) * (1.f / D) + EPS);
#pragma unroll
    for (int j = 0; j < 4; ++j) {
        const f32x4 gv = ((const f32x4*)g)[lane + 64 * j];
        f32x4 o = v[j] * rstd * gv;
        if (OUT_F32) ((f32x4*)((float*)out + (size_t)row * D))[lane + 64 * j] = o;
        else { uint2 w; w.x = f2bf(o.x) | (f2bf(o.y) << 16); w.y = f2bf(o.z) | (f2bf(o.w) << 16); ((uint2*)((bf16_t*)out + (size_t)row * D))[lane + 64 * j] = w; }
    }
}

enum { EPI_SWIGLU = 0, EPI_RESID = 1, EPI_BF16 = 2, EPI_F32 = 3 };
template <int EPI>
__global__ void __launch_bounds__(256) gemm_k(const bf16_t* A, int lda, const float* B1, const float* B2, int ldb, int N, int K,
                                              void* out, int ldo, const float* resid, float scale) {
    __shared__ __attribute__((aligned(16))) bf16_t sA[128 * 40];
    __shared__ __attribute__((aligned(16))) bf16_t sB1[128 * 40];
    __shared__ __attribute__((aligned(16))) bf16_t sB2[EPI == EPI_SWIGLU ? 128 * 40 : 8];
    const int tid = threadIdx.x, lane = tid & 63, wid = tid >> 6, wr = wid >> 1, wc = wid & 1;
    const int m0 = blockIdx.y * 128, n0 = blockIdx.x * 128;
    f32x4 acc1[4][4], acc2[4][4];
#pragma unroll
    for (int m = 0; m < 4; ++m)
#pragma unroll
        for (int n = 0; n < 4; ++n) { acc1[m][n] = (f32x4){0.f, 0.f, 0.f, 0.f}; acc2[m][n] = (f32x4){0.f, 0.f, 0.f, 0.f}; }
    for (int k0 = 0; k0 < K; k0 += 32) {
#pragma unroll
        for (int i = 0; i < 2; ++i) {
            const int idx = tid + 256 * i, row = idx >> 2, kc = (idx & 3) * 8;
            const uint4 v = *(const uint4*)(A + (size_t)(m0 + row) * lda + k0 + kc);
            *(uint4*)(sA + row * 40 + kc) = v;
        }
#pragma unroll
        for (int i = 0; i < 4; ++i) {
            const int kk = (tid >> 5) + 8 * i, n4 = (tid & 31) * 4;
            f32x4 v = (f32x4){0.f, 0.f, 0.f, 0.f};
            if (n0 + n4 < N) v = *(const f32x4*)(B1 + (size_t)(k0 + kk) * ldb + n0 + n4);
            sB1[(n4 + 0) * 40 + kk] = (bf16_t)f2bf(v.x); sB1[(n4 + 1) * 40 + kk] = (bf16_t)f2bf(v.y);
            sB1[(n4 + 2) * 40 + kk] = (bf16_t)f2bf(v.z); sB1[(n4 + 3) * 40 + kk] = (bf16_t)f2bf(v.w);
            if (EPI == EPI_SWIGLU) {
                f32x4 u = (f32x4){0.f, 0.f, 0.f, 0.f};
                if (n0 + n4 < N) u = *(const f32x4*)(B2 + (size_t)(k0 + kk) * ldb + n0 + n4);
                sB2[(n4 + 0) * 40 + kk] = (bf16_t)f2bf(u.x); sB2[(n4 + 1) * 40 + kk] = (bf16_t)f2bf(u.y);
                sB2[(n4 + 2) * 40 + kk] = (bf16_t)f2bf(u.z); sB2[(n4 + 3) * 40 + kk] = (bf16_t)f2bf(u.w);
            }
        }
        __syncthreads();
        bf16x8 a[4], b[4];
#pragma unroll
        for (int m = 0; m < 4; ++m) a[m] = *(const bf16x8*)(sA + (wr * 64 + m * 16 + (lane & 15)) * 40 + (lane >> 4) * 8);
#pragma unroll
        for (int n = 0; n < 4; ++n) b[n] = *(const bf16x8*)(sB1 + (wc * 64 + n * 16 + (lane & 15)) * 40 + (lane >> 4) * 8);
#pragma unroll
        for (int m = 0; m < 4; ++m)
#pragma unroll
            for (int n = 0; n < 4; ++n) acc1[m][n] = __builtin_amdgcn_mfma_f32_16x16x32_bf16(a[m], b[n], acc1[m][n], 0, 0, 0);
        if (EPI == EPI_SWIGLU) {
#pragma unroll
            for (int n = 0; n < 4; ++n) b[n] = *(const bf16x8*)(sB2 + (wc * 64 + n * 16 + (lane & 15)) * 40 + (lane >> 4) * 8);
#pragma unroll
            for (int m = 0; m < 4; ++m)
#pragma unroll
                for (int n = 0; n < 4; ++n) acc2[m][n] = __builtin_amdgcn_mfma_f32_16x16x32_bf16(a[m], b[n], acc2[m][n], 0, 0, 0);
        }
        __syncthreads();
    }
#pragma unroll
    for (int m = 0; m < 4; ++m)
#pragma unroll
        for (int n = 0; n < 4; ++n)
#pragma unroll
            for (int r = 0; r < 4; ++r) {
                const int row = m0 + wr * 64 + m * 16 + (lane >> 4) * 4 + r, col = n0 + wc * 64 + n * 16 + (lane & 15);
                if (col < N) {
                    const size_t o = (size_t)row * ldo + col;
                    const float v = acc1[m][n][r];
                    if (EPI == EPI_SWIGLU) { ((bf16_t*)out)[o] = (bf16_t)f2bf(siluf_(v) * acc2[m][n][r]); }
                    else if (EPI == EPI_RESID) { ((float*)out)[o] = resid[o] + scale * v; }
                    else if (EPI == EPI_BF16) { ((bf16_t*)out)[o] = (bf16_t)f2bf(v); }
                    else { ((float*)out)[o] = v; }
                }
            }
}

__global__ void __launch_bounds__(64) rg_golden(const bf16_t* P, const float* conv_w, const float* conv_b, const float* wa, const float* ba,
                                                const float* wx, const float* bx, const float* lam, float* HR, bf16_t* Y) {
    __shared__ __attribute__((aligned(16))) float xs[64][64];
    __shared__ float hrs[64][64];
    __shared__ float gs[64][64];
    const int j = threadIdx.x, b = blockIdx.x >> 3, blk = blockIdx.x & 7, c = blk * 64 + j;
    float cw[4];
#pragma unroll
    for (int t = 0; t < 4; ++t) cw[t] = conv_w[t * 512 + c];
    const float cb = conv_b[c];
    for (int d = 0; d < 2; ++d) {
        float wav[64], wxv[64];
#pragma unroll
        for (int i = 0; i < 64; ++i) { wav[i] = wa[((size_t)(d * 8 + blk) * 64 + i) * 64 + j]; wxv[i] = wx[((size_t)(d * 8 + blk) * 64 + i) * 64 + j]; }
        const float bav = ba[d * 512 + c], bxv = bx[d * 512 + c];
        const float sp = log1pf(expf(-lam[d * 512 + c]));
        float h = 0.f;
        for (int tb = 0; tb < SEQ / 64; ++tb) {
            __syncthreads();
            for (int tt = 0; tt < 64; ++tt) {
                const int t = d == 0 ? tb * 64 + tt : SEQ - 1 - (tb * 64 + tt);
                float acc = cb;
#pragma unroll
                for (int tap = 0; tap < 4; ++tap) { const int ts = t + tap - 2; if (ts >= 0 && ts < SEQ) acc += cw[tap] * bf2f(P[(size_t)(b * SEQ + ts) * NP + c]); }
                xs[tt][j] = acc;
                if (d == 1) { const size_t row = (size_t)(b * SEQ + t); hrs[tt][j] = HR[row * 512 + c]; gs[tt][j] = bf2f(P[row * NP + 512 + c]); }
            }
            __syncthreads();
            for (int tt = 0; tt < 64; ++tt) {
                const int t = d == 0 ? tb * 64 + tt : SEQ - 1 - (tb * 64 + tt);
                float rp = bav, ip = bxv;
#pragma unroll
                for (int i = 0; i < 64; i += 4) {
                    const f32x4 xv = *(const f32x4*)&xs[tt][i];
                    rp += xv.x * wav[i] + xv.y * wav[i + 1] + xv.z * wav[i + 2] + xv.w * wav[i + 3];
                    ip += xv.x * wxv[i] + xv.y * wxv[i + 1] + xv.z * wxv[i + 2] + xv.w * wxv[i + 3];
                }
                const float r = sigmoidf_(rp), ig = sigmoidf_(ip);
                const float la = -8.f * r * sp, a = expf(la);
                const float bb = sqrtf(-expm1f(2.f * la)) * (ig * xs[tt][j]);
                h = a * h + bb;
                const size_t row = (size_t)(b * SEQ + t);
                if (d == 0) HR[row * 512 + c] = h;
                else Y[row * 1024 + c] = (bf16_t)f2bf((hrs[tt][j] + h) * gelu_tanh(gs[tt][j]));
            }
        }
    }
}

__global__ void __launch_bounds__(128) gdn_golden(const bf16_t* P, const float* BA, const float* conv_w, const float* a_log, const float* dt_bias,
                                                  float* OF, float* OB) {
    constexpr int TB = 32;
    __shared__ __attribute__((aligned(16))) float qs[TB][128];
    __shared__ __attribute__((aligned(16))) float ks[TB][128];
    __shared__ float vs[TB][128];
    __shared__ float nq[TB], nk[TB], sbeta[TB], salpha[TB];
    const int v = threadIdx.x, d = blockIdx.x & 1, h = (blockIdx.x >> 1) & 3, b = blockIdx.x >> 3;
    float S[128];
#pragma unroll
    for (int i = 0; i < 128; ++i) S[i] = 0.f;
    const int cq = h * 128 + v, ck = 512 + h * 128 + v, cv = 1024 + h * 128 + v;
    float wq[4], wk[4], wv[4];
#pragma unroll
    for (int t = 0; t < 4; ++t) { wq[t] = conv_w[t * 1536 + cq]; wk[t] = conv_w[t * 1536 + ck]; wv[t] = conv_w[t * 1536 + cv]; }
    const float Ad = expf(a_log[d * 4 + h]), dtb = dt_bias[d * 4 + h];
    float* O = d ? OB : OF;
    for (int tb = 0; tb < SEQ / TB; ++tb) {
        __syncthreads();
        for (int tt = 0; tt < TB; ++tt) {
            const int t = d == 0 ? tb * TB + tt : SEQ - 1 - (tb * TB + tt);
            float aq = 0.f, ak = 0.f, av = 0.f;
#pragma unroll
            for (int tap = 0; tap < 4; ++tap) {
                const int ts = t + tap - 2;
                if (ts >= 0 && ts < SEQ) {
                    const bf16_t* pr = P + (size_t)(b * SEQ + ts) * NP + 1024;
                    aq += wq[tap] * bf2f(pr[cq]); ak += wk[tap] * bf2f(pr[ck]); av += wv[tap] * bf2f(pr[cv]);
                }
            }
            qs[tt][v] = siluf_(aq); ks[tt][v] = siluf_(ak); vs[tt][v] = siluf_(av);
        }
        __syncthreads();
        if (v < TB) { float s = 0.f; for (int i = 0; i < 128; ++i) s += qs[v][i] * qs[v][i]; nq[v] = rsqrtf(s + EPS) * 0.08838834764831845f; }
        else if (v < 2 * TB) { const int tt = v - TB; float s = 0.f; for (int i = 0; i < 128; ++i) s += ks[tt][i] * ks[tt][i]; nk[tt] = rsqrtf(s + EPS); }
        else if (v < 3 * TB) {
            const int tt = v - 2 * TB; const int t = d == 0 ? tb * TB + tt : SEQ - 1 - (tb * TB + tt);
            const float* bar = BA + (size_t)(b * SEQ + t) * 16;
            sbeta[tt] = sigmoidf_(bar[d * 4 + h]);
            const float x = bar[8 + d * 4 + h] + dtb;
            const float sp = x > 20.f ? x : log1pf(expf(x));
            salpha[tt] = expf(-Ad * sp);
        }
        __syncthreads();
        for (int tt = 0; tt < TB; ++tt) {
            const int t = d == 0 ? tb * TB + tt : SEQ - 1 - (tb * TB + tt);
            float pr = 0.f;
#pragma unroll
            for (int i = 0; i < 128; i += 4) { const f32x4 kv = *(const f32x4*)&ks[tt][i]; pr += kv.x * S[i] + kv.y * S[i + 1] + kv.z * S[i + 2] + kv.w * S[i + 3]; }
            const float kn = nk[tt], al = salpha[tt], be = sbeta[tt];
            const float delta = be * (vs[tt][v] - al * kn * pr);
            const float dk = delta * kn;
            float o = 0.f;
#pragma unroll
            for (int i = 0; i < 128; i += 4) {
                const f32x4 kv = *(const f32x4*)&ks[tt][i]; const f32x4 qv = *(const f32x4*)&qs[tt][i];
                S[i] = al * S[i] + kv.x * dk; S[i + 1] = al * S[i + 1] + kv.y * dk; S[i + 2] = al * S[i + 2] + kv.z * dk; S[i + 3] = al * S[i + 3] + kv.w * dk;
                o += qv.x * S[i] + qv.y * S[i + 1] + qv.z * S[i + 2] + qv.w * S[i + 3];
            }
            O[(size_t)(b * SEQ + t) * 512 + h * 128 + v] = o * nq[tt];
        }
    }
}

__global__ void __launch_bounds__(256) gdn_out_k(const float* OF, const float* OB, const bf16_t* P, const float* gnorm, bf16_t* Y) {
    const int lane = threadIdx.x & 63, gw = blockIdx.x * 4 + (threadIdx.x >> 6), row = gw >> 2, h = gw & 3;
    const size_t o = (size_t)row * 512 + h * 128 + 2 * lane;
    const float o0 = OF[o] + OB[o], o1 = OF[o + 1] + OB[o + 1];
    const float r = rsqrtf(wave_sum(o0 * o0 + o1 * o1) * (1.f / 128.f) + EPS);
    const bf16_t* z = P + (size_t)row * NP + 2560 + h * 128 + 2 * lane;
    const float y0 = o0 * r * gnorm[2 * lane] * siluf_(bf2f(z[0])), y1 = o1 * r * gnorm[2 * lane + 1] * siluf_(bf2f(z[1]));
    *(unsigned*)(Y + (size_t)row * 1024 + 512 + h * 128 + 2 * lane) = f2bf(y0) | (f2bf(y1) << 16);
}

extern "C" void kernel_launch(void* const* d_in, const int* in_sizes, int n_in, void* d_out, int out_size, void* d_ws, size_t ws_size, hipStream_t stream) {
    if (n_in != 24 || out_size != M * D || ws_size < 226 * MiB) { fprintf(stderr, "kernel_launch: unexpected shapes (n_in %d out %d ws %zu)\n", n_in, out_size, ws_size); return; }
    const float* x = (const float*)d_in[0];
    const float* g1 = (const float*)d_in[1]; const float* wg1 = (const float*)d_in[2]; const float* wu1 = (const float*)d_in[3]; const float* wd1 = (const float*)d_in[4];
    const float* gm = (const float*)d_in[5]; const float* w_in = (const float*)d_in[6]; const float* w_out = (const float*)d_in[7];
    const float* rg_cw = (const float*)d_in[8]; const float* rg_cb = (const float*)d_in[9]; const float* rg_wa = (const float*)d_in[10]; const float* rg_ba = (const float*)d_in[11];
    const float* rg_wx = (const float*)d_in[12]; const float* rg_bx = (const float*)d_in[13]; const float* rg_lam = (const float*)d_in[14];
    const float* gdn_cw = (const float*)d_in[15]; const float* gdn_alog = (const float*)d_in[16]; const float* gdn_dtb = (const float*)d_in[17]; const float* gdn_norm = (const float*)d_in[18];
    const float* g2 = (const float*)d_in[19]; const float* wg2 = (const float*)d_in[20]; const float* wu2 = (const float*)d_in[21]; const float* wd2 = (const float*)d_in[22];
    const float* gf = (const float*)d_in[23];
    float* out = (float*)d_out; unsigned char* ws = (unsigned char*)d_ws;
    float* BA = (float*)(ws + WS_BA); bf16_t* XN = (bf16_t*)(ws + WS_XN); bf16_t* Pb = (bf16_t*)(ws + WS_P); bf16_t* H = Pb;
    float* HR = (float*)(ws + WS_HR); float* OF = (float*)(ws + WS_OF); float* OB = (float*)(ws + WS_OB);
    bf16_t* Y = XN;

    rmsnorm_rows<false><<<M / 4, 256, 0, stream>>>(x, g1, XN);
    gemm_k<EPI_SWIGLU><<<dim3(DFF / 128, M / 128), 256, 0, stream>>>(XN, D, wg1, wu1, DFF, DFF, D, H, DFF, nullptr, 0.f);
    gemm_k<EPI_RESID><<<dim3(D / 128, M / 128), 256, 0, stream>>>(H, DFF, wd1, nullptr, D, D, DFF, out, D, x, 0.5f);
    rmsnorm_rows<false><<<M / 4, 256, 0, stream>>>(out, gm, XN);
    gemm_k<EPI_BF16><<<dim3(NP / 128, M / 128), 256, 0, stream>>>(XN, D, w_in, nullptr, DIN, NP, D, Pb, NP, nullptr, 0.f);
    gemm_k<EPI_F32><<<dim3(1, M / 128), 256, 0, stream>>>(XN, D, w_in + NP, nullptr, DIN, 16, D, BA, 16, nullptr, 0.f);
    rg_golden<<<16, 64, 0, stream>>>(Pb, rg_cw, rg_cb, rg_wa, rg_ba, rg_wx, rg_bx, rg_lam, HR, Y);
    gdn_golden<<<16, 128, 0, stream>>>(Pb, BA, gdn_cw, gdn_alog, gdn_dtb, OF, OB);
    gdn_out_k<<<M, 256, 0, stream>>>(OF, OB, Pb, gdn_norm, Y);
    gemm_k<EPI_RESID><<<dim3(D / 128, M / 128), 256, 0, stream>>>(Y, D, w_out, nullptr, D, D, D, out, D, out, 1.0f);
    rmsnorm_rows<false><<<M / 4, 256, 0, stream>>>(out, g2, XN);
    gemm_k<EPI_SWIGLU><<<dim3(DFF / 128, M / 128), 256, 0, stream>>>(XN, D, wg2, wu2, DFF, DFF, D, H, DFF, nullptr, 0.f);
    gemm_k<EPI_RESID><<<dim3(D / 128, M / 128), 256, 0, stream>>>(H, DFF, wd2, nullptr, D, D, DFF, out, D, out, 0.5f);
    rmsnorm_rows<true><<<M / 4, 256, 0, stream>>>(out, gf, out);
}
```

```cpp
#include <hip/hip_runtime.h>
#include <stdint.h>
#include <cstdio>

namespace pg8 {
#define PG8_LAS __attribute__((address_space(3)))
typedef unsigned short bf16_t;
typedef short bf16x8 __attribute__((ext_vector_type(8)));
typedef float f32x4 __attribute__((ext_vector_type(4)));
typedef unsigned u32x4 __attribute__((ext_vector_type(4)));
constexpr int BM = 256, BK = 64, HALF = 128, HTB = HALF * BK * 2  , STAGE_BYTES = 8 * HTB, NXCD = 8, WGM = 8;

__host__ __device__ __forceinline__ int lds_byte(int r, int c) { const int st = (r >> 4) * 2 + (c >> 5), rr = r & 15, cc = c & 31, ob = rr * 64 + cc * 2; return st * 1024 + (ob ^ (((ob >> 9) & 1) << 5)); }
__host__ __device__ __forceinline__ void stage_rc(int b, int& R, int& C) { const int st = b / 1024, sb = b % 1024, swz = sb ^ (((sb >> 9) & 1) << 5); R = (st >> 1) * 16 + swz / 64; C = (st & 1) * 32 + (swz % 64) / 2; }
__host__ __device__ __forceinline__ int perm32(int rho) { const int n = rho >> 4, i = rho & 15; return 8 * (i >> 2) + 4 * n + (i & 3); }

struct Unit { int pm, pn; };
struct Gemm { const bf16_t* A; const bf16_t* Bt; int M, N, K; };

struct StaticOrder {
    int nM, nN, nwg, G, c;
    __host__ __device__ void init(int M, int N, int G_, int c_) { nM = M / BM; nN = N / BM; nwg = nM * nN; G = G_; c = c_; }
    __host__ __device__ bool next(int i, Unit& u) const {
        const long L = (long)i * G + c; if (L >= nwg) return false;
        int wgid = (int)L; { const int q = nwg / NXCD, r = nwg % NXCD, xcd = wgid % NXCD, off = wgid / NXCD; wgid = (xcd < r ? xcd * (q + 1) : r * (q + 1) + (xcd - r) * q) + off; }
        const int nig = WGM * nN, gid = wgid / nig, fm = gid * WGM, gsz = (nM - fm) < WGM ? (nM - fm) : WGM;
        u.pm = fm + ((wgid % nig) % gsz); u.pn = (wgid % nig) / gsz; return true;
    }
    __device__ __forceinline__ void a_ready(const Unit&) const {}
    __device__ __forceinline__ void done(const Unit&) const {}
};


__device__ __forceinline__ unsigned cvt_pk_bf16(float lo, float hi) { unsigned r; asm volatile("v_cvt_pk_bf16_f32 %0, %1, %2" : "=v"(r) : "v"(lo), "v"(hi)); return r; }
constexpr float RMS_EPS = 1e-6f;
__device__ __forceinline__ float row_rstd(const float* ssq, int row) {
    const f32x4* p = (const f32x4*)(ssq + (size_t)row * 16);
    const f32x4 a = p[0], b = p[1], c = p[2], d = p[3];
    const float s = ((a[0] + a[1]) + (a[2] + a[3])) + ((b[0] + b[1]) + (b[2] + b[3])) + ((c[0] + c[1]) + (c[2] + c[3])) + ((d[0] + d[1]) + (d[2] + d[3]));
    return __builtin_amdgcn_rsqf(s * (1.0f / 1024.0f) + RMS_EPS);
}
__device__ __forceinline__ float silu_fast(float g) { return g * __builtin_amdgcn_rcpf(1.0f + __builtin_amdgcn_exp2f(-1.4426950408889634f * g)); }

struct EpiSwiGLU {
    static constexpr bool PERM = true, AFTER_DRAIN = false;
    bf16_t* H; int ldh; const float* ssq;
    __device__ __forceinline__ void operator()(const f32x4 (&acc)[2][2][4][2], const Unit& u, int wr, int wc, int fr, int fq) const {
        const int row0 = u.pm * BM + wr * 64 + fr, col0 = u.pn * HALF + wc * 32 + 8 * fq;
#pragma unroll
        for (int ai = 0; ai < 2; ++ai)
#pragma unroll
            for (int m = 0; m < 4; ++m) {
                const int row = row0 + ai * HALF + m * 16;
                const float rs = ssq ? row_rstd(ssq, row) : 1.0f;
                float h[8];
#pragma unroll
                for (int n = 0; n < 2; ++n)
#pragma unroll
                    for (int j = 0; j < 4; ++j) h[4 * n + j] = silu_fast(acc[ai][0][m][n][j] * rs) * (acc[ai][1][m][n][j] * rs);
                u32x4 w; w.x = cvt_pk_bf16(h[0], h[1]); w.y = cvt_pk_bf16(h[2], h[3]); w.z = cvt_pk_bf16(h[4], h[5]); w.w = cvt_pk_bf16(h[6], h[7]);
                *(u32x4*)(H + (size_t)row * ldh + col0) = w;
            }
    }
};
struct EpiScaleBf16 {
    static constexpr bool PERM = true, AFTER_DRAIN = false;
    bf16_t* O; int ldc; const float* ssq;
    __device__ __forceinline__ void operator()(const f32x4 (&acc)[2][2][4][2], const Unit& u, int wr, int wc, int fr, int fq) const {
        const int row0 = u.pm * BM + wr * 64 + fr, col0 = u.pn * BM + wc * 32 + 8 * fq;
#pragma unroll
        for (int ai = 0; ai < 2; ++ai)
#pragma unroll
            for (int m = 0; m < 4; ++m) {
                const int row = row0 + ai * HALF + m * 16;
                const float rs = row_rstd(ssq, row);
                bf16_t* rowp = O + (size_t)row * ldc + col0;
#pragma unroll
                for (int bj = 0; bj < 2; ++bj) { const f32x4 v0 = acc[ai][bj][m][0] * rs, v1 = acc[ai][bj][m][1] * rs;
                    u32x4 w; w.x = cvt_pk_bf16(v0[0], v0[1]); w.y = cvt_pk_bf16(v0[2], v0[3]); w.z = cvt_pk_bf16(v1[0], v1[1]); w.w = cvt_pk_bf16(v1[2], v1[3]);
                    *(u32x4*)(rowp + bj * HALF) = w; }
            }
    }
};
struct EpiResid {
    static constexpr bool PERM = false, AFTER_DRAIN = false;
    const float* resid; float* out; int ldc; float scale; const float* gain; bf16_t* xn; float* ssq;
    __device__ __forceinline__ void operator()(const f32x4 (&acc)[2][2][4][2], const Unit& u, int wr, int wc, int fr, int fq) const {
        typedef unsigned u32x2v __attribute__((ext_vector_type(2)));
        const int row0 = u.pm * BM + wr * 64 + fr, col0 = u.pn * BM + wc * 32 + 4 * fq;
        f32x4 gv[2][2];
#pragma unroll
        for (int bj = 0; bj < 2; ++bj)
#pragma unroll
            for (int n = 0; n < 2; ++n) gv[bj][n] = xn ? *(const f32x4*)(gain + col0 + bj * HALF + n * 16) : (f32x4){1.f, 1.f, 1.f, 1.f};
#pragma unroll
        for (int ai = 0; ai < 2; ++ai)
#pragma unroll
            for (int m = 0; m < 4; ++m) {
                const int row = row0 + ai * HALF + m * 16; const size_t off = (size_t)row * ldc + col0;
                float s = 0.f;
#pragma unroll
                for (int bj = 0; bj < 2; ++bj)
#pragma unroll
                    for (int n = 0; n < 2; ++n) {
                        const f32x4 r = *(const f32x4*)(resid + off + bj * HALF + n * 16);
                        const f32x4 o = r + acc[ai][bj][m][n] * scale;
                        *(f32x4*)(out + off + bj * HALF + n * 16) = o;
                        s += (o[0] * o[0] + o[1] * o[1]) + (o[2] * o[2] + o[3] * o[3]);
                        if (xn) { const f32x4 y = o * gv[bj][n]; u32x2v w; w.x = cvt_pk_bf16(y[0], y[1]); w.y = cvt_pk_bf16(y[2], y[3]); *(u32x2v*)(xn + off + bj * HALF + n * 16) = w; }
                    }
                s += __shfl_xor(s, 16); s += __shfl_xor(s, 32);
                if (fq == 0) ssq[(size_t)row * 16 + u.pn * 4 + wc] = s;
                asm volatile("" ::: "memory");
            }
    }
};
template <class Epi, class Sched, bool ALIGN_EPI = false, bool SP2 = false>
__device__ __forceinline__ void gemm_phase(PG8_LAS unsigned char* lds, const Gemm g, const Sched& S, const Epi& E) {
    const int tid = threadIdx.x, wid = __builtin_amdgcn_readfirstlane(tid >> 6), lane = tid & 63, wr = wid >> 2, wc = wid & 3, fr = lane & 15, fq = lane >> 4;
    const int K = g.K, nt = K / BK;
    unsigned voffA[2], voffB[2];
#pragma unroll
    for (int i = 0; i < 2; ++i) { int R, C; stage_rc(tid * 16 + i * 8192, R, C); const int Rb = Epi::PERM ? ((R & ~31) + perm32(R & 31)) : R;
        voffA[i] = (unsigned)(R * K + C) * 2u; voffB[i] = (unsigned)(Rb * K + C) * 2u; }
    const size_t kstep = (size_t)(BK * 2);
    const size_t hstep = (size_t)HALF * K * 2;
    const size_t tstep = 2 * hstep;
    const unsigned ldsw = (unsigned)wid * 1024u;
    const int aoff = lds_byte(wr * 64 + fr, fq * 8), boff = lds_byte(wc * 32 + fr, fq * 8);
#define PG8_SA(b, h) (((b) * 2 + (h)) * HTB)
#define PG8_SB(b, h) ((4 + (b) * 2 + (h)) * HTB)
#define PG8_STAGE(bufoff, gbase, voff) do { _Pragma("unroll") for (int _i = 0; _i < 2; ++_i) \
        __builtin_amdgcn_global_load_lds((const unsigned*)((const char*)(gbase) + (voff)[_i]), (PG8_LAS unsigned*)(lds + (bufoff) + ldsw + _i * 8192), 16, 0, 0); } while (0)
#define PG8_LDA(dst, b, h) do { _Pragma("unroll") for (int m = 0; m < 4; ++m) _Pragma("unroll") for (int k = 0; k < 2; ++k) dst[m][k] = *(const PG8_LAS bf16x8*)(lds + PG8_SA(b, h) + aoff + m * 2048 + k * 1024); } while (0)
#define PG8_LDB(dst, b, h) do { _Pragma("unroll") for (int n = 0; n < 2; ++n) _Pragma("unroll") for (int k = 0; k < 2; ++k) dst[n][k] = *(const PG8_LAS bf16x8*)(lds + PG8_SB(b, h) + boff + n * 2048 + k * 1024); } while (0)
#define PG8_MMA(ai, bj, At, Bt) do { __builtin_amdgcn_s_setprio(1); _Pragma("unroll") for (int m = 0; m < 4; ++m) _Pragma("unroll") for (int n = 0; n < 2; ++n) _Pragma("unroll") for (int k = 0; k < 2; ++k) \
        acc[ai][bj][m][n] = __builtin_amdgcn_mfma_f32_16x16x32_bf16(Bt[n][k], At[m][k], acc[ai][bj][m][n], 0, 0, 0); __builtin_amdgcn_s_setprio(0); } while (0)
#define PG8_WAIT_V(n) asm volatile("s_waitcnt vmcnt(" #n ")" ::: "memory")
#define PG8_WAIT_L(n) asm volatile("s_waitcnt lgkmcnt(" #n ")" ::: "memory")
#define PG8_BAR __builtin_amdgcn_s_barrier()
#define PG8_SCHED __builtin_amdgcn_sched_barrier(0)
    Unit cur, nxt; int ui = 0;
    if (!S.next(0, cur)) return;
    f32x4 acc[2][2][4][2];
#pragma unroll
    for (int a = 0; a < 2; ++a)
#pragma unroll
        for (int b = 0; b < 2; ++b)
#pragma unroll
            for (int m = 0; m < 4; ++m)
#pragma unroll
                for (int n = 0; n < 2; ++n) acc[a][b][m][n] = (f32x4){0.f, 0.f, 0.f, 0.f};
    bf16x8 At[4][2], B0[2][2], B1[2][2];
    const char* cA = (const char*)g.A + (size_t)cur.pm * tstep; const char* cB = (const char*)g.Bt + (size_t)cur.pn * tstep;
    S.a_ready(cur);
    if constexpr (SP2) {
        PG8_STAGE(PG8_SB(0, 0), cB, voffB); PG8_STAGE(PG8_SB(0, 1), cB + hstep, voffB); PG8_STAGE(PG8_SA(0, 0), cA, voffA); PG8_STAGE(PG8_SA(0, 1), cA + hstep, voffA);
        if (wr == 1) PG8_BAR;
        PG8_WAIT_V(2); PG8_BAR;
        PG8_STAGE(PG8_SB(1, 0), cB + kstep, voffB); PG8_STAGE(PG8_SA(1, 0), cA + kstep, voffA); PG8_STAGE(PG8_SB(1, 1), cB + hstep + kstep, voffB);
        PG8_WAIT_V(6); PG8_BAR;
    } else {
        PG8_STAGE(PG8_SB(0, 0), cB, voffB); PG8_STAGE(PG8_SA(0, 0), cA, voffA); PG8_STAGE(PG8_SB(0, 1), cB + hstep, voffB); PG8_STAGE(PG8_SA(0, 1), cA + hstep, voffA);
        if (wr == 1) PG8_BAR;
        PG8_WAIT_V(4); PG8_BAR;
        PG8_STAGE(PG8_SB(1, 0), cB + kstep, voffB); PG8_STAGE(PG8_SA(1, 0), cA + kstep, voffA); PG8_STAGE(PG8_SB(1, 1), cB + hstep + kstep, voffB);
        PG8_WAIT_V(6); PG8_BAR;
    }
    for (;;) {
        const bool has_next = S.next(ui + 1, nxt);
        const char* nA = has_next ? (const char*)g.A + (size_t)nxt.pm * tstep : cA; const char* nB = has_next ? (const char*)g.Bt + (size_t)nxt.pn * tstep : cB;
        for (int t = 0; t < nt; t += 2) {
            const bool last = (t == nt - 2);
            const char* a1 = cA + (size_t)(t + 1) * kstep;
            const char* a2 = last ? nA : cA + (size_t)(t + 2) * kstep; const char* b2 = last ? nB : cB + (size_t)(t + 2) * kstep;
            const char* a3 = a2 + kstep; const char* b3 = b2 + kstep;
            if (last && has_next) S.a_ready(nxt);
            if constexpr (SP2) {
            PG8_LDB(B0, 0, 0); PG8_LDB(B1, 0, 1); PG8_SCHED; PG8_LDA(At, 0, 0); PG8_STAGE(PG8_SA(1, 1), a1 + hstep, voffA);
            PG8_WAIT_V(8); PG8_WAIT_L(0); PG8_BAR; PG8_MMA(0, 0, At, B0); PG8_MMA(0, 1, At, B1); PG8_BAR; PG8_SCHED;
            PG8_LDA(At, 0, 1); PG8_STAGE(PG8_SB(0, 0), b2, voffB); PG8_STAGE(PG8_SB(0, 1), b2 + hstep, voffB); PG8_STAGE(PG8_SA(0, 0), a2, voffA);
            PG8_WAIT_V(8); PG8_WAIT_L(0); PG8_BAR; PG8_MMA(1, 0, At, B0); PG8_MMA(1, 1, At, B1); PG8_BAR; PG8_SCHED;
            PG8_LDB(B0, 1, 0); PG8_LDB(B1, 1, 1); PG8_SCHED; PG8_LDA(At, 1, 0); PG8_STAGE(PG8_SA(0, 1), a2 + hstep, voffA);
            PG8_WAIT_V(8); PG8_WAIT_L(0); PG8_BAR; PG8_MMA(0, 0, At, B0); PG8_MMA(0, 1, At, B1); PG8_BAR; PG8_SCHED;
            PG8_LDA(At, 1, 1); PG8_STAGE(PG8_SB(1, 0), b3, voffB); PG8_STAGE(PG8_SB(1, 1), b3 + hstep, voffB); PG8_STAGE(PG8_SA(1, 0), a3, voffA);
            PG8_WAIT_V(8); PG8_WAIT_L(0); PG8_BAR; PG8_MMA(1, 0, At, B0); PG8_MMA(1, 1, At, B1); PG8_BAR; PG8_SCHED;
            } else {
            PG8_LDB(B0, 0, 0); PG8_SCHED; PG8_LDA(At, 0, 0); PG8_STAGE(PG8_SA(1, 1), a1 + hstep, voffA);
            PG8_WAIT_L(8); PG8_BAR; PG8_WAIT_L(0); PG8_MMA(0, 0, At, B0); PG8_BAR; PG8_SCHED;
            PG8_LDB(B1, 0, 1); PG8_STAGE(PG8_SB(0, 0), b2, voffB);
            PG8_BAR; PG8_WAIT_L(0); PG8_MMA(0, 1, At, B1); PG8_BAR;
            PG8_LDA(At, 0, 1); PG8_STAGE(PG8_SA(0, 0), a2, voffA);
            PG8_BAR; PG8_WAIT_L(0); PG8_MMA(1, 0, At, B0); PG8_BAR; PG8_SCHED;
            PG8_STAGE(PG8_SB(0, 1), b2 + hstep, voffB);
            PG8_WAIT_V(6); PG8_BAR; PG8_MMA(1, 1, At, B1); PG8_BAR;
            PG8_LDB(B0, 1, 0); PG8_SCHED; PG8_LDA(At, 1, 0); PG8_STAGE(PG8_SA(0, 1), a2 + hstep, voffA);
            PG8_WAIT_L(8); PG8_BAR; PG8_WAIT_L(0); PG8_MMA(0, 0, At, B0); PG8_BAR; PG8_SCHED;
            PG8_LDB(B1, 1, 1); PG8_STAGE(PG8_SB(1, 0), b3, voffB);
            PG8_BAR; PG8_WAIT_L(0); PG8_MMA(0, 1, At, B1); PG8_BAR;
            PG8_LDA(At, 1, 1); PG8_STAGE(PG8_SA(1, 0), a3, voffA);
            PG8_BAR; PG8_WAIT_L(0); PG8_MMA(1, 0, At, B0); PG8_BAR; PG8_SCHED;
            PG8_STAGE(PG8_SB(1, 1), b3 + hstep, voffB);
            PG8_WAIT_V(6); PG8_BAR; PG8_MMA(1, 1, At, B1); PG8_BAR;
            }
        }
        if constexpr (ALIGN_EPI) { if (wr == 0) PG8_BAR; }
        if constexpr (!Epi::AFTER_DRAIN) { E(acc, cur, wr, wc, fr, fq); S.done(cur); }
        if (!has_next) break;
#pragma unroll
        for (int a = 0; a < 2; ++a)
#pragma unroll
            for (int b = 0; b < 2; ++b)
#pragma unroll
                for (int m = 0; m < 4; ++m)
#pragma unroll
                    for (int n = 0; n < 2; ++n) acc[a][b][m][n] = (f32x4){0.f, 0.f, 0.f, 0.f};
        cur = nxt; cA = nA; cB = nB; ++ui;
        if constexpr (ALIGN_EPI) { if (wr == 1) PG8_BAR; }
    }
    PG8_WAIT_V(0);
    if constexpr (!ALIGN_EPI) { if (wr == 0) PG8_BAR; }
    PG8_BAR;
    if constexpr (Epi::AFTER_DRAIN) { E.fused(acc, cur, wr, wc, fr, fq, lds, wid, lane); S.done(cur); }
#undef PG8_SA
#undef PG8_SB
#undef PG8_STAGE
#undef PG8_LDA
#undef PG8_LDB
#undef PG8_MMA
#undef PG8_WAIT_V
#undef PG8_WAIT_L
#undef PG8_BAR
#undef PG8_SCHED
}
}

constexpr int NWAVES = 8;
constexpr int BATCH = 2, SEQ = 8192, D = 1024, M = BATCH * SEQ, DFF = 2816, DIN = 3088, NP = 3072, NGU = 2 * DFF;
constexpr float EPS = 1e-6f;
constexpr size_t MiB = 1u << 20;
constexpr size_t WS_CTL = 0, CTL_ZERO_BYTES = 1 * MiB;
constexpr size_t WS_BA = 1 * MiB;
constexpr size_t WS_SSQ = 2 * MiB;
constexpr size_t WS_WBA = 3 * MiB;
constexpr size_t WS_WGU1 = 4 * MiB;
constexpr size_t WS_WD1 = 15 * MiB;
constexpr size_t WS_WIN = WS_WD1 + 5632 * 1024;
constexpr size_t WS_WOUT = WS_WIN + 6 * MiB;
constexpr size_t WS_WGU2 = WS_WOUT + 2 * MiB;
constexpr size_t WS_WD2 = WS_WGU2 + 11 * MiB;
constexpr size_t WS_XN = 46 * MiB;
constexpr size_t WS_P = 78 * MiB;
constexpr size_t WS_HR = 174 * MiB;
constexpr size_t WS_XN3 = 174 * MiB;
constexpr size_t WS_OF = 206 * MiB;
constexpr size_t WS_END = 238 * MiB;
constexpr int CW_BAR = 4096;
constexpr int RING_OFF = 0, RING_BYTES = 131072;
constexpr int LDSCTL_OFF = RING_BYTES, MISC_OFF = LDSCTL_OFF + 320;
constexpr int LDS_BYTES = 147456;

#define GAS __attribute__((address_space(1)))
#define LAS __attribute__((address_space(3)))
typedef unsigned short bf16;
typedef unsigned v4u __attribute__((ext_vector_type(4)));
typedef float f32x4 __attribute__((ext_vector_type(4)));
typedef short bf16x8 __attribute__((ext_vector_type(8)));
typedef GAS unsigned gu32;
#define RLX_AGENT __ATOMIC_RELAXED, __HIP_MEMORY_SCOPE_AGENT
#define LDS_WAIT() asm volatile("s_waitcnt lgkmcnt(0)" ::: "memory")
#define VM_WAIT() asm volatile("s_waitcnt vmcnt(0)" ::: "memory")
__device__ __forceinline__ unsigned f2bf(float f) { unsigned u = __builtin_bit_cast(unsigned, f); return (u + 0x7fffu + ((u >> 16) & 1u)) >> 16; }
__device__ __forceinline__ unsigned pk2(float lo, float hi) { return f2bf(lo) | (f2bf(hi) << 16); }
__device__ __forceinline__ float bf2f(bf16 b) { return __uint_as_float((unsigned)b << 16); }
__device__ __forceinline__ float wave_sum(float v) {
#pragma unroll
    for (int o = 1; o < 64; o <<= 1) v += __shfl_xor(v, o);
    return v;
}
typedef unsigned short bf16_t;
__device__ __forceinline__ float sigmoidf_(float x) { return 1.f / (1.f + expf(-x)); }
__device__ __forceinline__ float siluf_(float x) { return x / (1.f + expf(-x)); }
__device__ __forceinline__ float gelu_tanh(float x) { return 0.5f * x * (1.f + tanhf(0.7978845608028654f * (x + 0.044715f * x * x * x))); }
#define XB_TMO      128
#define XB_XCNT(j)  (256  + 64 * (j))
#define XB_XSUB(j)  (1280 + 64 * (j))
#define XB_XGEN(j)  (2304 + 64 * (j))
#define XB_TOP      3328
#define XB_TOPGEN   3392
#define XCD_BAR_WORDS 3456
#define XB_SPIN_CAP (1u << 18)

__device__ __forceinline__ unsigned xb_ld(unsigned* p)              { return __hip_atomic_load(p, __ATOMIC_RELAXED, __HIP_MEMORY_SCOPE_AGENT); }
__device__ __forceinline__ unsigned xb_add(unsigned* p, unsigned v) { return __hip_atomic_fetch_add(p, v, __ATOMIC_RELAXED, __HIP_MEMORY_SCOPE_AGENT); }
__device__ __forceinline__ unsigned xb_xcc_id() { return (unsigned)__builtin_amdgcn_s_getreg((3 << 11) | 20) & 0xFu; }
#define XB_SPIN(cond, bar) do { unsigned _sp = 0; while (cond) { __builtin_amdgcn_s_sleep(1); \
    if ((++_sp & 255u) == 0u) { if (xb_ld(&(bar)[XB_TMO])) break; if (_sp > XB_SPIN_CAP) { atomicAdd(&(bar)[XB_TMO], 1u); break; } } } } while (0)

struct XcdBarrier {
    unsigned* bar; unsigned x;
    volatile LAS unsigned* st;
};

__device__ __forceinline__ XcdBarrier xcd_barrier_post(unsigned* bar, volatile LAS unsigned* st) {
    XcdBarrier b; b.bar = bar; b.x = xb_xcc_id(); b.st = st;
    if (threadIdx.x == 0) (void)xb_add(&bar[XB_XCNT(b.x)], 1u);
    return b;
}
__device__ __forceinline__ void xcd_barrier_complete(unsigned* bar, unsigned x, unsigned& nloc, unsigned& nx) {
    const unsigned G = gridDim.x * gridDim.y * gridDim.z;
    unsigned sum, cnt, mine, sp = 0u;
    for (;;) {
        sum = 0u; cnt = 0u; mine = 0u;
#pragma unroll
        for (unsigned j = 0; j < 16; ++j) { const unsigned c = xb_ld(&bar[XB_XCNT(j)]); sum += c; cnt += (c > 0u) ? 1u : 0u; mine = (j == x) ? c : mine; }
        if (sum == G) break;
        __builtin_amdgcn_s_sleep(1);
        if ((++sp & 255u) == 0u) { if (xb_ld(&bar[XB_TMO])) break; if (sp > XB_SPIN_CAP) { atomicAdd(&bar[XB_TMO], 1u); break; } }
    }
    nloc = mine > 0u ? mine : 1u; nx = cnt > 0u ? cnt : 1u;
}

__device__ __forceinline__ void xcd_barrier(const XcdBarrier& b) {
    asm volatile("s_waitcnt vmcnt(0)" ::: "memory");
    __syncthreads();
    if (threadIdx.x == 0) {
        unsigned* bar = b.bar;
        __builtin_amdgcn_s_waitcnt(0);
        unsigned nloc = b.st[0], nx = b.st[1];
        if (nloc == 0u) { xcd_barrier_complete(bar, b.x, nloc, nx); b.st[0] = nloc; b.st[1] = nx; }
        const unsigned old = xb_add(&bar[XB_XSUB(b.x)], 1u);
        const unsigned gen = old / nloc;
        if (old + 1u == (gen + 1u) * nloc) {
            __builtin_amdgcn_fence(__ATOMIC_RELEASE, "agent");
            asm volatile("s_waitcnt vmcnt(0)" ::: "memory");
            const unsigned og = xb_add(&bar[XB_TOP], 1u);
            const unsigned tg = og / nx;
            if (og + 1u == (tg + 1u) * nx) xb_add(&bar[XB_TOPGEN], 1u);
            else XB_SPIN(xb_ld(&bar[XB_TOPGEN]) == tg, bar);
            __builtin_amdgcn_fence(__ATOMIC_ACQUIRE, "agent");
            xb_add(&bar[XB_XGEN(b.x)], 1u);
            asm volatile("s_waitcnt vmcnt(0)" ::: "memory");
        } else {
            XB_SPIN(xb_ld(&bar[XB_XGEN(b.x)]) == gen, bar);
            __builtin_amdgcn_fence(__ATOMIC_ACQUIRE, "agent");
            asm volatile("s_waitcnt vmcnt(0)" ::: "memory");
        }
    }
    __syncthreads();
}

struct Frame {
    LAS unsigned char* lds;
    volatile LAS unsigned* MISC;
    gu32* ctl;
    int tid, lane, wave, G;
};

__device__ __forceinline__ void p0_transpose_item(const float* W, int ldw, int K, bf16* WT, int drow0, int k0, int n0, LAS float* scr, int lane) {
#pragma unroll 8
    for (int i = 0; i < 32; ++i) { const int kk = 2 * i + (lane >> 5); scr[kk * 33 + (lane & 31)] = W[(size_t)(k0 + kk) * ldw + n0 + (lane & 31)]; }
    LDS_WAIT(); asm volatile("" ::: "memory");
    const int c = lane & 7;
#pragma unroll
    for (int j = 0; j < 4; ++j) { const int n = (lane >> 3) + 8 * j; const LAS float* s = scr + (8 * c) * 33 + n;
        v4u o; o.x = pk2(s[0 * 33], s[1 * 33]); o.y = pk2(s[2 * 33], s[3 * 33]); o.z = pk2(s[4 * 33], s[5 * 33]); o.w = pk2(s[6 * 33], s[7 * 33]);
        *(GAS v4u*)(WT + (size_t)(drow0 + n) * K + k0 + 8 * c) = o; }
    LDS_WAIT(); asm volatile("" ::: "memory");
}
__device__ __forceinline__ void rms_row_to_bf16(const float* xrow, const float* g, bf16* orow, int lane) {
    const GAS f32x4* xr = (const GAS f32x4*)xrow + lane;
    f32x4 v[4]; float s = 0.f;
#pragma unroll
    for (int j = 0; j < 4; ++j) { v[j] = xr[64 * j]; s += (v[j].x * v[j].x + v[j].y * v[j].y) + (v[j].z * v[j].z + v[j].w * v[j].w); }
    const float rstd = rsqrtf(wave_sum(s) * (1.f / D) + EPS);
    GAS unsigned long long* o8 = (GAS unsigned long long*)orow + lane;
#pragma unroll
    for (int j = 0; j < 4; ++j) { const f32x4 gv = ((const GAS f32x4*)g)[lane + 64 * j]; const f32x4 y = v[j] * rstd * gv;
        o8[64 * j] = (unsigned long long)pk2(y.x, y.y) | ((unsigned long long)pk2(y.z, y.w) << 32); }
}
__device__ __forceinline__ void rms_row_inplace(float* xrow, const float* g, int lane) {
    GAS f32x4* xr = (GAS f32x4*)xrow + lane;
    f32x4 v[4]; float s = 0.f;
#pragma unroll
    for (int j = 0; j < 4; ++j) { v[j] = xr[64 * j]; s += (v[j].x * v[j].x + v[j].y * v[j].y) + (v[j].z * v[j].z + v[j].w * v[j].w); }
    const float rstd = rsqrtf(wave_sum(s) * (1.f / D) + EPS);
#pragma unroll
    for (int j = 0; j < 4; ++j) { const f32x4 gv = ((const GAS f32x4*)g)[lane + 64 * j]; xr[64 * j] = v[j] * rstd * gv; }
}

struct Args { const float* in[24]; float* out; unsigned char* ws; int ph_lo, ph_hi; };

__device__ __forceinline__ void p0_prologue(Frame& F, const Args& args) {
    LAS float* scr = (LAS float*)(F.lds + RING_OFF + F.wave * 16384);
    unsigned char* ws = args.ws;
    const int gw = blockIdx.x * NWAVES + F.wave, NGW = F.G * NWAVES;
    constexpr int I_GU = (D / 64) * (DFF / 32);
    constexpr int I_DN = (DFF / 64) * (D / 32);
    constexpr int I_IN = (D / 64) * (NP / 32);
    constexpr int I_OUT = (D / 64) * (D / 32);
    constexpr int NITEMS = 4 * I_GU + 2 * I_DN + I_IN + I_OUT;
    for (int it = gw; it < NITEMS; it += NGW) {
        int r = it;
        if (r < 4 * I_GU) {
            const int which = r / I_GU; r -= which * I_GU;
            const float* W = args.in[which == 0 ? 2 : which == 1 ? 3 : which == 2 ? 20 : 21];
            bf16* WT = (bf16*)(ws + (which < 2 ? WS_WGU1 : WS_WGU2));
            const int nblk = DFF / 32, kb = r / nblk, nb = r % nblk, n0 = nb * 32;
            const int drow0 = (n0 >> 7) * 256 + (n0 & 127) + ((which & 1) ? 128 : 0);
            p0_transpose_item(W, DFF, D, WT, drow0, kb * 64, n0, scr, F.lane); continue;
        }
        r -= 4 * I_GU;
        if (r < 2 * I_DN) {
            const int which = r / I_DN; r -= which * I_DN;
            const float* W = args.in[which == 0 ? 4 : 22];
            bf16* WT = (bf16*)(ws + (which == 0 ? WS_WD1 : WS_WD2));
            const int nblk = D / 32, kb = r / nblk, nb = r % nblk;
            p0_transpose_item(W, D, DFF, WT, nb * 32, kb * 64, nb * 32, scr, F.lane); continue;
        }
        r -= 2 * I_DN;
        if (r < I_IN) { const int nblk = NP / 32, kb = r / nblk, nb = r % nblk;
            p0_transpose_item(args.in[6], DIN, D, (bf16*)(ws + WS_WIN), nb * 32, kb * 64, nb * 32, scr, F.lane); continue; }
        r -= I_IN;
        { const int nblk = D / 32, kb = r / nblk, nb = r % nblk;
          p0_transpose_item(args.in[7], D, D, (bf16*)(ws + WS_WOUT), nb * 32, kb * 64, nb * 32, scr, F.lane); }
    }
    { const int gt = blockIdx.x * (NWAVES * 64) + F.tid;
      if (gt < 16 * D) { const int j = gt >> 10, k = gt & 1023; ((bf16*)(ws + WS_WBA))[gt] = (bf16)f2bf(args.in[6][(size_t)k * DIN + NP + j]); } }
    for (int m = gw; m < M; m += NGW) rms_row_to_bf16(args.in[0] + (size_t)m * D, args.in[1], (bf16*)(ws + WS_XN) + (size_t)m * D, F.lane);
}

__device__ __forceinline__ void ba_tile(const bf16* XN, const bf16* Wba, const float* ssq, float* BA, int row0, int lane) {
    const int fr = lane & 15, fq = lane >> 4;
    f32x4 acc = (f32x4){0.f, 0.f, 0.f, 0.f};
    const bf16* ap = XN + (size_t)(row0 + fr) * D + fq * 8;
    const bf16* bp = Wba + (size_t)fr * D + fq * 8;
#pragma unroll 8
    for (int ks = 0; ks < D / 32; ++ks) {
        const bf16x8 a = *(const bf16x8*)(ap + ks * 32), b = *(const bf16x8*)(bp + ks * 32);
        acc = __builtin_amdgcn_mfma_f32_16x16x32_bf16(a, b, acc, 0, 0, 0);
    }
#pragma unroll
    for (int r = 0; r < 4; ++r) { const int row = row0 + 4 * fq + r; BA[(size_t)row * 16 + fr] = acc[r] * pg8::row_rstd(ssq, row); }
}

enum { PH_PRO = 0, PH_G1 = 1, PH_G2 = 2, PH_G3 = 3, PH_M1 = 4, PH_M2 = 5, PH_M3 = 6, PH_G4 = 7, PH_G5 = 8, PH_G6 = 9, PH_FIN = 10, PH_END = 11 };

__global__ void __launch_bounds__(NWAVES * 64, 2) mk_fwd(Args args) {
    extern __shared__ __attribute__((aligned(16))) unsigned char lds[];
    Frame F;
    F.lds = (LAS unsigned char*)lds;
    F.MISC = (volatile LAS unsigned*)(F.lds + MISC_OFF);
    F.tid = threadIdx.x; F.lane = F.tid & 63; F.wave = __builtin_amdgcn_readfirstlane(F.tid >> 6);
    F.G = gridDim.x;
    unsigned char* ws = args.ws;
    F.ctl = (gu32*)(ws + WS_CTL);
    for (int u = F.tid; u < (LDS_BYTES - LDSCTL_OFF) / 4; u += NWAVES * 64) ((LAS unsigned*)(F.lds + LDSCTL_OFF))[u] = 0u;
    __syncthreads();
    const int lo = args.ph_lo, hi = args.ph_hi;
    const bool multi = (hi - lo) > 1;
    XcdBarrier bar; bar.bar = (unsigned*)(F.ctl + CW_BAR); bar.x = 0; bar.st = nullptr;
    if (multi) bar = xcd_barrier_post((unsigned*)(F.ctl + CW_BAR), F.MISC + 8);
#define IN(k) (lo <= (k) && (k) < hi)
#define SEAM(k) do { if (IN((k) + 1)) xcd_barrier(bar); } while (0)

    float* out = args.out;
    bf16* XN = (bf16*)(ws + WS_XN); bf16* Pb = (bf16*)(ws + WS_P); bf16* H = Pb;
    float* SSQ = (float*)(ws + WS_SSQ); float* BA = (float*)(ws + WS_BA); bf16* XN3 = (bf16*)(ws + WS_XN3);

    if (IN(PH_PRO)) { p0_prologue(F, args); SEAM(PH_PRO); }

    if (IN(PH_G1)) {
        pg8::Gemm g{XN, (const bf16*)(ws + WS_WGU1), M, NGU, D}; pg8::StaticOrder S; S.init(M, NGU, F.G, (int)blockIdx.x);
        pg8::EpiSwiGLU E{H, DFF, nullptr};
        pg8::gemm_phase<pg8::EpiSwiGLU, pg8::StaticOrder, true, true>(F.lds + RING_OFF, g, S, E);
        SEAM(PH_G1);
    }
    if (IN(PH_G2)) {
        pg8::Gemm g{H, (const bf16*)(ws + WS_WD1), M, D, DFF}; pg8::StaticOrder S; S.init(M, D, F.G, (int)blockIdx.x);
        pg8::EpiResid E{args.in[0], out, D, 0.5f, args.in[5], XN, SSQ};
        pg8::gemm_phase<pg8::EpiResid, pg8::StaticOrder, true, true>(F.lds + RING_OFF, g, S, E);
        SEAM(PH_G2);
    }
    if (IN(PH_G3)) {
        pg8::Gemm g{XN, (const bf16*)(ws + WS_WIN), M, NP, D}; pg8::StaticOrder S; S.init(M, NP, F.G, (int)blockIdx.x);
        pg8::EpiScaleBf16 E{Pb, NP, SSQ};
        pg8::gemm_phase<pg8::EpiScaleBf16, pg8::StaticOrder, true, true>(F.lds + RING_OFF, g, S, E);
        for (int rt = blockIdx.x * NWAVES + F.wave; rt < M / 16; rt += F.G * NWAVES) ba_tile(XN, (const bf16*)(ws + WS_WBA), SSQ, BA, rt * 16, F.lane);
        SEAM(PH_G3);
    }
    if (IN(PH_G4)) {
        pg8::Gemm g{XN, (const bf16*)(ws + WS_WOUT), M, D, D}; pg8::StaticOrder S; S.init(M, D, F.G, (int)blockIdx.x);
        pg8::EpiResid E{out, out, D, 1.0f, args.in[19], XN3, SSQ};
        pg8::gemm_phase<pg8::EpiResid, pg8::StaticOrder, true, true>(F.lds + RING_OFF, g, S, E);
        SEAM(PH_G4);
    }
    if (IN(PH_G5)) {
        pg8::Gemm g{XN3, (const bf16*)(ws + WS_WGU2), M, NGU, D}; pg8::StaticOrder S; S.init(M, NGU, F.G, (int)blockIdx.x);
        pg8::EpiSwiGLU E{H, DFF, SSQ};
        pg8::gemm_phase<pg8::EpiSwiGLU, pg8::StaticOrder, true, true>(F.lds + RING_OFF, g, S, E);
        SEAM(PH_G5);
    }
    if (IN(PH_G6)) {
        pg8::Gemm g{H, (const bf16*)(ws + WS_WD2), M, D, DFF}; pg8::StaticOrder S; S.init(M, D, F.G, (int)blockIdx.x);
        pg8::EpiResid E{out, out, D, 0.5f, nullptr, nullptr, SSQ};
        pg8::gemm_phase<pg8::EpiResid, pg8::StaticOrder, true, true>(F.lds + RING_OFF, g, S, E);
        SEAM(PH_G6);
    }
    if (IN(PH_FIN)) {
        for (int m = blockIdx.x * NWAVES + F.wave; m < M; m += F.G * NWAVES) rms_row_inplace(out + (size_t)m * D, args.in[23], F.lane);
    }
#undef IN
#undef SEAM
}
__global__ void __launch_bounds__(64) rg_golden(const bf16_t* P, const float* conv_w, const float* conv_b, const float* wa, const float* ba,
                                                const float* wx, const float* bx, const float* lam, float* HR, bf16_t* Y) {
    __shared__ __attribute__((aligned(16))) float xs[64][64];
    __shared__ float hrs[64][64];
    __shared__ float gs[64][64];
    const int j = threadIdx.x, b = blockIdx.x >> 3, blk = blockIdx.x & 7, c = blk * 64 + j;
    float cw[4];
#pragma unroll
    for (int t = 0; t < 4; ++t) cw[t] = conv_w[t * 512 + c];
    const float cb = conv_b[c];
    for (int d = 0; d < 2; ++d) {
        float wav[64], wxv[64];
#pragma unroll
        for (int i = 0; i < 64; ++i) { wav[i] = wa[((size_t)(d * 8 + blk) * 64 + i) * 64 + j]; wxv[i] = wx[((size_t)(d * 8 + blk) * 64 + i) * 64 + j]; }
        const float bav = ba[d * 512 + c], bxv = bx[d * 512 + c];
        const float sp = log1pf(expf(-lam[d * 512 + c]));
        float h = 0.f;
        for (int tb = 0; tb < SEQ / 64; ++tb) {
            __syncthreads();
            for (int tt = 0; tt < 64; ++tt) {
                const int t = d == 0 ? tb * 64 + tt : SEQ - 1 - (tb * 64 + tt);
                float acc = cb;
#pragma unroll
                for (int tap = 0; tap < 4; ++tap) { const int ts = t + tap - 2; if (ts >= 0 && ts < SEQ) acc += cw[tap] * bf2f(P[(size_t)(b * SEQ + ts) * NP + c]); }
                xs[tt][j] = acc;
                if (d == 1) { const size_t row = (size_t)(b * SEQ + t); hrs[tt][j] = HR[row * 512 + c]; gs[tt][j] = bf2f(P[row * NP + 512 + c]); }
            }
            __syncthreads();
            for (int tt = 0; tt < 64; ++tt) {
                const int t = d == 0 ? tb * 64 + tt : SEQ - 1 - (tb * 64 + tt);
                float rp = bav, ip = bxv;
#pragma unroll
                for (int i = 0; i < 64; i += 4) {
                    const f32x4 xv = *(const f32x4*)&xs[tt][i];
                    rp += xv.x * wav[i] + xv.y * wav[i + 1] + xv.z * wav[i + 2] + xv.w * wav[i + 3];
                    ip += xv.x * wxv[i] + xv.y * wxv[i + 1] + xv.z * wxv[i + 2] + xv.w * wxv[i + 3];
                }
                const float r = sigmoidf_(rp), ig = sigmoidf_(ip);
                const float la = -8.f * r * sp, a = expf(la);
                const float bb = sqrtf(-expm1f(2.f * la)) * (ig * xs[tt][j]);
                h = a * h + bb;
                const size_t row = (size_t)(b * SEQ + t);
                if (d == 0) HR[row * 512 + c] = h;
                else Y[row * 1024 + c] = (bf16_t)f2bf((hrs[tt][j] + h) * gelu_tanh(gs[tt][j]));
            }
        }
    }
}

__global__ void __launch_bounds__(128) gdn_golden(const bf16_t* P, const float* BA, const float* conv_w, const float* a_log, const float* dt_bias,
                                                  float* OF, float* OB) {
    constexpr int TB = 32;
    __shared__ __attribute__((aligned(16))) float qs[TB][128];
    __shared__ __attribute__((aligned(16))) float ks[TB][128];
    __shared__ float vs[TB][128];
    __shared__ float nq[TB], nk[TB], sbeta[TB], salpha[TB];
    const int v = threadIdx.x, d = blockIdx.x & 1, h = (blockIdx.x >> 1) & 3, b = blockIdx.x >> 3;
    float S[128];
#pragma unroll
    for (int i = 0; i < 128; ++i) S[i] = 0.f;
    const int cq = h * 128 + v, ck = 512 + h * 128 + v, cv = 1024 + h * 128 + v;
    float wq[4], wk[4], wv[4];
#pragma unroll
    for (int t = 0; t < 4; ++t) { wq[t] = conv_w[t * 1536 + cq]; wk[t] = conv_w[t * 1536 + ck]; wv[t] = conv_w[t * 1536 + cv]; }
    const float Ad = expf(a_log[d * 4 + h]), dtb = dt_bias[d * 4 + h];
    float* O = d ? OB : OF;
    for (int tb = 0; tb < SEQ / TB; ++tb) {
        __syncthreads();
        for (int tt = 0; tt < TB; ++tt) {
            const int t = d == 0 ? tb * TB + tt : SEQ - 1 - (tb * TB + tt);
            float aq = 0.f, ak = 0.f, av = 0.f;
#pragma unroll
            for (int tap = 0; tap < 4; ++tap) {
                const int ts = t + tap - 2;
                if (ts >= 0 && ts < SEQ) {
                    const bf16_t* pr = P + (size_t)(b * SEQ + ts) * NP + 1024;
                    aq += wq[tap] * bf2f(pr[cq]); ak += wk[tap] * bf2f(pr[ck]); av += wv[tap] * bf2f(pr[cv]);
                }
            }
            qs[tt][v] = siluf_(aq); ks[tt][v] = siluf_(ak); vs[tt][v] = siluf_(av);
        }
        __syncthreads();
        if (v < TB) { float s = 0.f; for (int i = 0; i < 128; ++i) s += qs[v][i] * qs[v][i]; nq[v] = rsqrtf(s + EPS) * 0.08838834764831845f; }
        else if (v < 2 * TB) { const int tt = v - TB; float s = 0.f; for (int i = 0; i < 128; ++i) s += ks[tt][i] * ks[tt][i]; nk[tt] = rsqrtf(s + EPS); }
        else if (v < 3 * TB) {
            const int tt = v - 2 * TB; const int t = d == 0 ? tb * TB + tt : SEQ - 1 - (tb * TB + tt);
            const float* bar = BA + (size_t)(b * SEQ + t) * 16;
            sbeta[tt] = sigmoidf_(bar[d * 4 + h]);
            const float x = bar[8 + d * 4 + h] + dtb;
            const float sp = x > 20.f ? x : log1pf(expf(x));
            salpha[tt] = expf(-Ad * sp);
        }
        __syncthreads();
        for (int tt = 0; tt < TB; ++tt) {
            const int t = d == 0 ? tb * TB + tt : SEQ - 1 - (tb * TB + tt);
            float pr = 0.f;
#pragma unroll
            for (int i = 0; i < 128; i += 4) { const f32x4 kv = *(const f32x4*)&ks[tt][i]; pr += kv.x * S[i] + kv.y * S[i + 1] + kv.z * S[i + 2] + kv.w * S[i + 3]; }
            const float kn = nk[tt], al = salpha[tt], be = sbeta[tt];
            const float delta = be * (vs[tt][v] - al * kn * pr);
            const float dk = delta * kn;
            float o = 0.f;
#pragma unroll
            for (int i = 0; i < 128; i += 4) {
                const f32x4 kv = *(const f32x4*)&ks[tt][i]; const f32x4 qv = *(const f32x4*)&qs[tt][i];
                S[i] = al * S[i] + kv.x * dk; S[i + 1] = al * S[i + 1] + kv.y * dk; S[i + 2] = al * S[i + 2] + kv.z * dk; S[i + 3] = al * S[i + 3] + kv.w * dk;
                o += qv.x * S[i] + qv.y * S[i + 1] + qv.z * S[i + 2] + qv.w * S[i + 3];
            }
            O[(size_t)(b * SEQ + t) * 512 + h * 128 + v] = o * nq[tt];
        }
    }
}

__global__ void __launch_bounds__(256) gdn_out_k(const float* OF, const float* OB, const bf16_t* P, const float* gnorm, bf16_t* Y) {
    const int lane = threadIdx.x & 63, gw = blockIdx.x * 4 + (threadIdx.x >> 6), row = gw >> 2, h = gw & 3;
    const size_t o = (size_t)row * 512 + h * 128 + 2 * lane;
    const float o0 = OF[o] + OB[o], o1 = OF[o + 1] + OB[o + 1];
    const float r = rsqrtf(wave_sum(o0 * o0 + o1 * o1) * (1.f / 128.f) + EPS);
    const bf16_t* z = P + (size_t)row * NP + 2560 + h * 128 + 2 * lane;
    const float y0 = o0 * r * gnorm[2 * lane] * siluf_(bf2f(z[0])), y1 = o1 * r * gnorm[2 * lane + 1] * siluf_(bf2f(z[1]));
    *(unsigned*)(Y + (size_t)row * 1024 + 512 + h * 128 + 2 * lane) = f2bf(y0) | (f2bf(y1) << 16);
}


extern "C" void kernel_launch(void* const* d_in, const int* in_sizes, int n_in, void* d_out, int out_size, void* d_ws, size_t ws_size, hipStream_t stream) {
    static int grid = 0;
    if (grid == 0) {
        if (n_in != 24 || in_sizes[0] != M * D || out_size != M * D || ws_size < WS_END) { fprintf(stderr, "kernel_launch: unexpected shapes (n_in %d, out %d, ws %zu); nothing launched\n", n_in, out_size, ws_size); grid = -1; return; }
        int dev = 0, cus = 0, per_cu = 0;
        if (hipGetDevice(&dev) != hipSuccess || hipDeviceGetAttribute(&cus, hipDeviceAttributeMultiprocessorCount, dev) != hipSuccess) { fprintf(stderr, "kernel_launch: device query failed\n"); grid = -1; return; }
        if (hipFuncSetAttribute((const void*)mk_fwd, hipFuncAttributeMaxDynamicSharedMemorySize, LDS_BYTES) != hipSuccess) { fprintf(stderr, "kernel_launch: hipFuncSetAttribute failed\n"); grid = -1; return; }
        if (hipOccupancyMaxActiveBlocksPerMultiprocessor(&per_cu, (const void*)mk_fwd, NWAVES * 64, LDS_BYTES) != hipSuccess || per_cu < 1)
            fprintf(stderr, "kernel_launch: note: occupancy query reports %d workgroups per CU\n", per_cu);
        (void)hipGetLastError();
        grid = cus;
    }
    if (grid < 0) return;
    if (hipMemsetAsync((char*)d_ws + WS_CTL, 0, CTL_ZERO_BYTES, stream) != hipSuccess) { fprintf(stderr, "kernel_launch: memset failed\n"); return; }
    Args a{};
    for (int i = 0; i < 24; ++i) a.in[i] = (const float*)d_in[i];
    a.out = (float*)d_out; a.ws = (unsigned char*)d_ws;
    unsigned char* ws = (unsigned char*)d_ws;
    auto launch = [&](int lo, int hi) { a.ph_lo = lo; a.ph_hi = hi; hipLaunchKernelGGL(mk_fwd, dim3(grid), dim3(NWAVES * 64), LDS_BYTES, stream, a); };
    launch(PH_PRO, PH_G1); launch(PH_G1, PH_G2); launch(PH_G2, PH_G3); launch(PH_G3, PH_M1);
    {
        const bf16_t* Pb = (const bf16_t*)(ws + WS_P); float* BA = (float*)(ws + WS_BA); float* HR = (float*)(ws + WS_HR); float* OF = (float*)(ws + WS_OF); float* OB = HR;
        bf16_t* Y = (bf16_t*)(ws + WS_XN);
        rg_golden<<<16, 64, 0, stream>>>(Pb, a.in[8], a.in[9], a.in[10], a.in[11], a.in[12], a.in[13], a.in[14], HR, Y);
        gdn_golden<<<16, 128, 0, stream>>>(Pb, BA, a.in[15], a.in[16], a.in[17], OF, OB);
        gdn_out_k<<<M, 256, 0, stream>>>(OF, OB, Pb, a.in[18], Y);
    }
    launch(PH_G4, PH_G5); launch(PH_G5, PH_G6); launch(PH_G6, PH_FIN); launch(PH_FIN, PH_END);
}
```

```cpp
#include <hip/hip_runtime.h>
#include <stdint.h>
#include <cstdio>

namespace pg8 {
#define PG8_LAS __attribute__((address_space(3)))
typedef unsigned short bf16_t;
typedef short bf16x8 __attribute__((ext_vector_type(8)));
typedef float f32x4 __attribute__((ext_vector_type(4)));
typedef unsigned u32x4 __attribute__((ext_vector_type(4)));
constexpr int BM = 256, BK = 64, HALF = 128, HTB = HALF * BK * 2  , STAGE_BYTES = 8 * HTB, NXCD = 8, WGM = 8;

__host__ __device__ __forceinline__ int lds_byte(int r, int c) { const int st = (r >> 4) * 2 + (c >> 5), rr = r & 15, cc = c & 31, ob = rr * 64 + cc * 2; return st * 1024 + (ob ^ (((ob >> 9) & 1) << 5)); }
__host__ __device__ __forceinline__ void stage_rc(int b, int& R, int& C) { const int st = b / 1024, sb = b % 1024, swz = sb ^ (((sb >> 9) & 1) << 5); R = (st >> 1) * 16 + swz / 64; C = (st & 1) * 32 + (swz % 64) / 2; }
__host__ __device__ __forceinline__ int perm32(int rho) { const int n = rho >> 4, i = rho & 15; return 8 * (i >> 2) + 4 * n + (i & 3); }

struct Unit { int pm, pn; };
struct Gemm { const bf16_t* A; const bf16_t* Bt; int M, N, K; };

struct StaticOrder {
    int nM, nN, nwg, G, c;
    __host__ __device__ void init(int M, int N, int G_, int c_) { nM = M / BM; nN = N / BM; nwg = nM * nN; G = G_; c = c_; }
    __host__ __device__ bool next(int i, Unit& u) const {
        const long L = (long)i * G + c; if (L >= nwg) return false;
        int wgid = (int)L; { const int q = nwg / NXCD, r = nwg % NXCD, xcd = wgid % NXCD, off = wgid / NXCD; wgid = (xcd < r ? xcd * (q + 1) : r * (q + 1) + (xcd - r) * q) + off; }
        const int nig = WGM * nN, gid = wgid / nig, fm = gid * WGM, gsz = (nM - fm) < WGM ? (nM - fm) : WGM;
        u.pm = fm + ((wgid % nig) % gsz); u.pn = (wgid % nig) / gsz; return true;
    }
    __device__ __forceinline__ void a_ready(const Unit&) const {}
    __device__ __forceinline__ void done(const Unit&) const {}
};


__device__ __forceinline__ unsigned cvt_pk_bf16(float lo, float hi) { unsigned r; asm volatile("v_cvt_pk_bf16_f32 %0, %1, %2" : "=v"(r) : "v"(lo), "v"(hi)); return r; }
constexpr float RMS_EPS = 1e-6f;
__device__ __forceinline__ float row_rstd(const float* ssq, int row) {
    const f32x4* p = (const f32x4*)(ssq + (size_t)row * 16);
    const f32x4 a = p[0], b = p[1], c = p[2], d = p[3];
    const float s = ((a[0] + a[1]) + (a[2] + a[3])) + ((b[0] + b[1]) + (b[2] + b[3])) + ((c[0] + c[1]) + (c[2] + c[3])) + ((d[0] + d[1]) + (d[2] + d[3]));
    return __builtin_amdgcn_rsqf(s * (1.0f / 1024.0f) + RMS_EPS);
}
__device__ __forceinline__ float silu_fast(float g) { return g * __builtin_amdgcn_rcpf(1.0f + __builtin_amdgcn_exp2f(-1.4426950408889634f * g)); }

struct EpiSwiGLU {
    static constexpr bool PERM = true, AFTER_DRAIN = false;
    bf16_t* H; int ldh; const float* ssq;
    __device__ __forceinline__ void operator()(const f32x4 (&acc)[2][2][4][2], const Unit& u, int wr, int wc, int fr, int fq) const {
        const int row0 = u.pm * BM + wr * 64 + fr, col0 = u.pn * HALF + wc * 32 + 8 * fq;
#pragma unroll
        for (int ai = 0; ai < 2; ++ai)
#pragma unroll
            for (int m = 0; m < 4; ++m) {
                const int row = row0 + ai * HALF + m * 16;
                const float rs = ssq ? row_rstd(ssq, row) : 1.0f;
                float h[8];
#pragma unroll
                for (int n = 0; n < 2; ++n)
#pragma unroll
                    for (int j = 0; j < 4; ++j) h[4 * n + j] = silu_fast(acc[ai][0][m][n][j] * rs) * (acc[ai][1][m][n][j] * rs);
                u32x4 w; w.x = cvt_pk_bf16(h[0], h[1]); w.y = cvt_pk_bf16(h[2], h[3]); w.z = cvt_pk_bf16(h[4], h[5]); w.w = cvt_pk_bf16(h[6], h[7]);
                *(u32x4*)(H + (size_t)row * ldh + col0) = w;
            }
    }
};
struct EpiScaleBf16 {
    static constexpr bool PERM = true, AFTER_DRAIN = false;
    bf16_t* O; int ldc; const float* ssq;
    __device__ __forceinline__ void operator()(const f32x4 (&acc)[2][2][4][2], const Unit& u, int wr, int wc, int fr, int fq) const {
        const int row0 = u.pm * BM + wr * 64 + fr, col0 = u.pn * BM + wc * 32 + 8 * fq;
#pragma unroll
        for (int ai = 0; ai < 2; ++ai)
#pragma unroll
            for (int m = 0; m < 4; ++m) {
                const int row = row0 + ai * HALF + m * 16;
                const float rs = row_rstd(ssq, row);
                bf16_t* rowp = O + (size_t)row * ldc + col0;
#pragma unroll
                for (int bj = 0; bj < 2; ++bj) { const f32x4 v0 = acc[ai][bj][m][0] * rs, v1 = acc[ai][bj][m][1] * rs;
                    u32x4 w; w.x = cvt_pk_bf16(v0[0], v0[1]); w.y = cvt_pk_bf16(v0[2], v0[3]); w.z = cvt_pk_bf16(v1[0], v1[1]); w.w = cvt_pk_bf16(v1[2], v1[3]);
                    *(u32x4*)(rowp + bj * HALF) = w; }
            }
    }
};
struct EpiResid {
    static constexpr bool PERM = false, AFTER_DRAIN = false;
    const float* resid; float* out; int ldc; float scale; const float* gain; bf16_t* xn; float* ssq;
    __device__ __forceinline__ void operator()(const f32x4 (&acc)[2][2][4][2], const Unit& u, int wr, int wc, int fr, int fq) const {
        typedef unsigned u32x2v __attribute__((ext_vector_type(2)));
        const int row0 = u.pm * BM + wr * 64 + fr, col0 = u.pn * BM + wc * 32 + 4 * fq;
        f32x4 gv[2][2];
#pragma unroll
        for (int bj = 0; bj < 2; ++bj)
#pragma unroll
            for (int n = 0; n < 2; ++n) gv[bj][n] = xn ? *(const f32x4*)(gain + col0 + bj * HALF + n * 16) : (f32x4){1.f, 1.f, 1.f, 1.f};
#pragma unroll
        for (int ai = 0; ai < 2; ++ai)
#pragma unroll
            for (int m = 0; m < 4; ++m) {
                const int row = row0 + ai * HALF + m * 16; const size_t off = (size_t)row * ldc + col0;
                float s = 0.f;
#pragma unroll
                for (int bj = 0; bj < 2; ++bj)
#pragma unroll
                    for (int n = 0; n < 2; ++n) {
                        const f32x4 r = *(const f32x4*)(resid + off + bj * HALF + n * 16);
                        const f32x4 o = r + acc[ai][bj][m][n] * scale;
                        *(f32x4*)(out + off + bj * HALF + n * 16) = o;
                        s += (o[0] * o[0] + o[1] * o[1]) + (o[2] * o[2] + o[3] * o[3]);
                        if (xn) { const f32x4 y = o * gv[bj][n]; u32x2v w; w.x = cvt_pk_bf16(y[0], y[1]); w.y = cvt_pk_bf16(y[2], y[3]); *(u32x2v*)(xn + off + bj * HALF + n * 16) = w; }
                    }
                s += __shfl_xor(s, 16); s += __shfl_xor(s, 32);
                if (fq == 0) ssq[(size_t)row * 16 + u.pn * 4 + wc] = s;
                asm volatile("" ::: "memory");
            }
    }
};
template <class Epi, class Sched, bool ALIGN_EPI = false, bool SP2 = false>
__device__ __forceinline__ void gemm_phase(PG8_LAS unsigned char* lds, const Gemm g, const Sched& S, const Epi& E) {
    const int tid = threadIdx.x, wid = __builtin_amdgcn_readfirstlane(tid >> 6), lane = tid & 63, wr = wid >> 2, wc = wid & 3, fr = lane & 15, fq = lane >> 4;
    const int K = g.K, nt = K / BK;
    unsigned voffA[2], voffB[2];
#pragma unroll
    for (int i = 0; i < 2; ++i) { int R, C; stage_rc(tid * 16 + i * 8192, R, C); const int Rb = Epi::PERM ? ((R & ~31) + perm32(R & 31)) : R;
        voffA[i] = (unsigned)(R * K + C) * 2u; voffB[i] = (unsigned)(Rb * K + C) * 2u; }
    const size_t kstep = (size_t)(BK * 2);
    const size_t hstep = (size_t)HALF * K * 2;
    const size_t tstep = 2 * hstep;
    const unsigned ldsw = (unsigned)wid * 1024u;
    const int aoff = lds_byte(wr * 64 + fr, fq * 8), boff = lds_byte(wc * 32 + fr, fq * 8);
#define PG8_SA(b, h) (((b) * 2 + (h)) * HTB)
#define PG8_SB(b, h) ((4 + (b) * 2 + (h)) * HTB)
#define PG8_STAGE(bufoff, gbase, voff) do { _Pragma("unroll") for (int _i = 0; _i < 2; ++_i) \
        __builtin_amdgcn_global_load_lds((const unsigned*)((const char*)(gbase) + (voff)[_i]), (PG8_LAS unsigned*)(lds + (bufoff) + ldsw + _i * 8192), 16, 0, 0); } while (0)
#define PG8_LDA(dst, b, h) do { _Pragma("unroll") for (int m = 0; m < 4; ++m) _Pragma("unroll") for (int k = 0; k < 2; ++k) dst[m][k] = *(const PG8_LAS bf16x8*)(lds + PG8_SA(b, h) + aoff + m * 2048 + k * 1024); } while (0)
#define PG8_LDB(dst, b, h) do { _Pragma("unroll") for (int n = 0; n < 2; ++n) _Pragma("unroll") for (int k = 0; k < 2; ++k) dst[n][k] = *(const PG8_LAS bf16x8*)(lds + PG8_SB(b, h) + boff + n * 2048 + k * 1024); } while (0)
#define PG8_MMA(ai, bj, At, Bt) do { __builtin_amdgcn_s_setprio(1); _Pragma("unroll") for (int m = 0; m < 4; ++m) _Pragma("unroll") for (int n = 0; n < 2; ++n) _Pragma("unroll") for (int k = 0; k < 2; ++k) \
        acc[ai][bj][m][n] = __builtin_amdgcn_mfma_f32_16x16x32_bf16(Bt[n][k], At[m][k], acc[ai][bj][m][n], 0, 0, 0); __builtin_amdgcn_s_setprio(0); } while (0)
#define PG8_WAIT_V(n) asm volatile("s_waitcnt vmcnt(" #n ")" ::: "memory")
#define PG8_WAIT_L(n) asm volatile("s_waitcnt lgkmcnt(" #n ")" ::: "memory")
#define PG8_BAR __builtin_amdgcn_s_barrier()
#define PG8_SCHED __builtin_amdgcn_sched_barrier(0)
    Unit cur, nxt; int ui = 0;
    if (!S.next(0, cur)) return;
    f32x4 acc[2][2][4][2];
#pragma unroll
    for (int a = 0; a < 2; ++a)
#pragma unroll
        for (int b = 0; b < 2; ++b)
#pragma unroll
            for (int m = 0; m < 4; ++m)
#pragma unroll
                for (int n = 0; n < 2; ++n) acc[a][b][m][n] = (f32x4){0.f, 0.f, 0.f, 0.f};
    bf16x8 At[4][2], B0[2][2], B1[2][2];
    const char* cA = (const char*)g.A + (size_t)cur.pm * tstep; const char* cB = (const char*)g.Bt + (size_t)cur.pn * tstep;
    S.a_ready(cur);
    if constexpr (SP2) {
        PG8_STAGE(PG8_SB(0, 0), cB, voffB); PG8_STAGE(PG8_SB(0, 1), cB + hstep, voffB); PG8_STAGE(PG8_SA(0, 0), cA, voffA); PG8_STAGE(PG8_SA(0, 1), cA + hstep, voffA);
        if (wr == 1) PG8_BAR;
        PG8_WAIT_V(2); PG8_BAR;
        PG8_STAGE(PG8_SB(1, 0), cB + kstep, voffB); PG8_STAGE(PG8_SA(1, 0), cA + kstep, voffA); PG8_STAGE(PG8_SB(1, 1), cB + hstep + kstep, voffB);
        PG8_WAIT_V(6); PG8_BAR;
    } else {
        PG8_STAGE(PG8_SB(0, 0), cB, voffB); PG8_STAGE(PG8_SA(0, 0), cA, voffA); PG8_STAGE(PG8_SB(0, 1), cB + hstep, voffB); PG8_STAGE(PG8_SA(0, 1), cA + hstep, voffA);
        if (wr == 1) PG8_BAR;
        PG8_WAIT_V(4); PG8_BAR;
        PG8_STAGE(PG8_SB(1, 0), cB + kstep, voffB); PG8_STAGE(PG8_SA(1, 0), cA + kstep, voffA); PG8_STAGE(PG8_SB(1, 1), cB + hstep + kstep, voffB);
        PG8_WAIT_V(6); PG8_BAR;
    }
    for (;;) {
        const bool has_next = S.next(ui + 1, nxt);
        const char* nA = has_next ? (const char*)g.A + (size_t)nxt.pm * tstep : cA; const char* nB = has_next ? (const char*)g.Bt + (size_t)nxt.pn * tstep : cB;
        for (int t = 0; t < nt; t += 2) {
            const bool last = (t == nt - 2);
            const char* a1 = cA + (size_t)(t + 1) * kstep;
            const char* a2 = last ? nA : cA + (size_t)(t + 2) * kstep; const char* b2 = last ? nB : cB + (size_t)(t + 2) * kstep;
            const char* a3 = a2 + kstep; const char* b3 = b2 + kstep;
            if (last && has_next) S.a_ready(nxt);
            if constexpr (SP2) {
            PG8_LDB(B0, 0, 0); PG8_LDB(B1, 0, 1); PG8_SCHED; PG8_LDA(At, 0, 0); PG8_STAGE(PG8_SA(1, 1), a1 + hstep, voffA);
            PG8_WAIT_V(8); PG8_WAIT_L(0); PG8_BAR; PG8_MMA(0, 0, At, B0); PG8_MMA(0, 1, At, B1); PG8_BAR; PG8_SCHED;
            PG8_LDA(At, 0, 1); PG8_STAGE(PG8_SB(0, 0), b2, voffB); PG8_STAGE(PG8_SB(0, 1), b2 + hstep, voffB); PG8_STAGE(PG8_SA(0, 0), a2, voffA);
            PG8_WAIT_V(8); PG8_WAIT_L(0); PG8_BAR; PG8_MMA(1, 0, At, B0); PG8_MMA(1, 1, At, B1); PG8_BAR; PG8_SCHED;
            PG8_LDB(B0, 1, 0); PG8_LDB(B1, 1, 1); PG8_SCHED; PG8_LDA(At, 1, 0); PG8_STAGE(PG8_SA(0, 1), a2 + hstep, voffA);
            PG8_WAIT_V(8); PG8_WAIT_L(0); PG8_BAR; PG8_MMA(0, 0, At, B0); PG8_MMA(0, 1, At, B1); PG8_BAR; PG8_SCHED;
            PG8_LDA(At, 1, 1); PG8_STAGE(PG8_SB(1, 0), b3, voffB); PG8_STAGE(PG8_SB(1, 1), b3 + hstep, voffB); PG8_STAGE(PG8_SA(1, 0), a3, voffA);
            PG8_WAIT_V(8); PG8_WAIT_L(0); PG8_BAR; PG8_MMA(1, 0, At, B0); PG8_MMA(1, 1, At, B1); PG8_BAR; PG8_SCHED;
            } else {
            PG8_LDB(B0, 0, 0); PG8_SCHED; PG8_LDA(At, 0, 0); PG8_STAGE(PG8_SA(1, 1), a1 + hstep, voffA);
            PG8_WAIT_L(8); PG8_BAR; PG8_WAIT_L(0); PG8_MMA(0, 0, At, B0); PG8_BAR; PG8_SCHED;
            PG8_LDB(B1, 0, 1); PG8_STAGE(PG8_SB(0, 0), b2, voffB);
            PG8_BAR; PG8_WAIT_L(0); PG8_MMA(0, 1, At, B1); PG8_BAR;
            PG8_LDA(At, 0, 1); PG8_STAGE(PG8_SA(0, 0), a2, voffA);
            PG8_BAR; PG8_WAIT_L(0); PG8_MMA(1, 0, At, B0); PG8_BAR; PG8_SCHED;
            PG8_STAGE(PG8_SB(0, 1), b2 + hstep, voffB);
            PG8_WAIT_V(6); PG8_BAR; PG8_MMA(1, 1, At, B1); PG8_BAR;
            PG8_LDB(B0, 1, 0); PG8_SCHED; PG8_LDA(At, 1, 0); PG8_STAGE(PG8_SA(0, 1), a2 + hstep, voffA);
            PG8_WAIT_L(8); PG8_BAR; PG8_WAIT_L(0); PG8_MMA(0, 0, At, B0); PG8_BAR; PG8_SCHED;
            PG8_LDB(B1, 1, 1); PG8_STAGE(PG8_SB(1, 0), b3, voffB);
            PG8_BAR; PG8_WAIT_L(0); PG8_MMA(0, 1, At, B1); PG8_BAR;
            PG8_LDA(At, 1, 1); PG8_STAGE(PG8_SA(1, 0), a3, voffA);
            PG8_BAR; PG8_WAIT_L(0); PG8_MMA(1, 0, At, B0); PG8_BAR; PG8_SCHED;
            PG8_STAGE(PG8_SB(1, 1), b3 + hstep, voffB);
            PG8_WAIT_V(6); PG8_BAR; PG8_MMA(1, 1, At, B1); PG8_BAR;
            }
        }
        if constexpr (ALIGN_EPI) { if (wr == 0) PG8_BAR; }
        if constexpr (!Epi::AFTER_DRAIN) { E(acc, cur, wr, wc, fr, fq); S.done(cur); }
        if (!has_next) break;
#pragma unroll
        for (int a = 0; a < 2; ++a)
#pragma unroll
            for (int b = 0; b < 2; ++b)
#pragma unroll
                for (int m = 0; m < 4; ++m)
#pragma unroll
                    for (int n = 0; n < 2; ++n) acc[a][b][m][n] = (f32x4){0.f, 0.f, 0.f, 0.f};
        cur = nxt; cA = nA; cB = nB; ++ui;
        if constexpr (ALIGN_EPI) { if (wr == 1) PG8_BAR; }
    }
    PG8_WAIT_V(0);
    if constexpr (!ALIGN_EPI) { if (wr == 0) PG8_BAR; }
    PG8_BAR;
    if constexpr (Epi::AFTER_DRAIN) { E.fused(acc, cur, wr, wc, fr, fq, lds, wid, lane); S.done(cur); }
#undef PG8_SA
#undef PG8_SB
#undef PG8_STAGE
#undef PG8_LDA
#undef PG8_LDB
#undef PG8_MMA
#undef PG8_WAIT_V
#undef PG8_WAIT_L
#undef PG8_BAR
#undef PG8_SCHED
}
}

constexpr int NWAVES = 8;
constexpr int BATCH = 2, SEQ = 8192, D = 1024, M = BATCH * SEQ, DFF = 2816, DIN = 3088, NP = 3072, NGU = 2 * DFF;
constexpr float EPS = 1e-6f;
constexpr size_t MiB = 1u << 20;
constexpr size_t WS_CTL = 0, CTL_ZERO_BYTES = 1 * MiB;
constexpr size_t WS_BA = 1 * MiB;
constexpr size_t WS_SSQ = 2 * MiB;
constexpr size_t WS_WBA = 3 * MiB;
constexpr size_t WS_WGU1 = 4 * MiB;
constexpr size_t WS_WD1 = 15 * MiB;
constexpr size_t WS_WIN = WS_WD1 + 5632 * 1024;
constexpr size_t WS_WOUT = WS_WIN + 6 * MiB;
constexpr size_t WS_WGU2 = WS_WOUT + 2 * MiB;
constexpr size_t WS_WD2 = WS_WGU2 + 11 * MiB;
constexpr size_t WS_XN = 46 * MiB;
constexpr size_t WS_P = 78 * MiB;
constexpr size_t WS_XN3 = 174 * MiB;
constexpr size_t WS_CD = 45 * MiB;
constexpr size_t WS_UU = 46 * MiB;
constexpr size_t WS_WQC = 174 * MiB;
constexpr size_t WS_KTC = 206 * MiB;
constexpr size_t WS_SS = 238 * MiB;
constexpr size_t WS_RGW = 3 * MiB + 65536;
constexpr size_t WS_RGS = 254 * MiB;
constexpr size_t WS_END = 256 * MiB;
constexpr int CW_BAR = 4096;
constexpr int RING_OFF = 0, RING_BYTES = 131072;
constexpr int LDSCTL_OFF = RING_BYTES, MISC_OFF = LDSCTL_OFF + 320;
constexpr int LDS_BYTES = 147456;

#define GAS __attribute__((address_space(1)))
#define LAS __attribute__((address_space(3)))
typedef unsigned short bf16;
typedef unsigned v4u __attribute__((ext_vector_type(4)));
typedef float f32x4 __attribute__((ext_vector_type(4)));
typedef short bf16x8 __attribute__((ext_vector_type(8)));
typedef GAS unsigned gu32;
#define RLX_AGENT __ATOMIC_RELAXED, __HIP_MEMORY_SCOPE_AGENT
#define LDS_WAIT() asm volatile("s_waitcnt lgkmcnt(0)" ::: "memory")
#define VM_WAIT() asm volatile("s_waitcnt vmcnt(0)" ::: "memory")
__device__ __forceinline__ unsigned f2bf(float f) { unsigned u = __builtin_bit_cast(unsigned, f); return (u + 0x7fffu + ((u >> 16) & 1u)) >> 16; }
__device__ __forceinline__ unsigned pk2(float lo, float hi) { return f2bf(lo) | (f2bf(hi) << 16); }
__device__ __forceinline__ float bf2f(bf16 b) { return __uint_as_float((unsigned)b << 16); }
__device__ __forceinline__ float wave_sum(float v) {
#pragma unroll
    for (int o = 1; o < 64; o <<= 1) v += __shfl_xor(v, o);
    return v;
}
typedef unsigned short bf16_t;
__device__ __forceinline__ float sigmoidf_(float x) { return 1.f / (1.f + expf(-x)); }
__device__ __forceinline__ float siluf_(float x) { return x / (1.f + expf(-x)); }
__device__ __forceinline__ float gelu_tanh(float x) { return 0.5f * x * (1.f + tanhf(0.7978845608028654f * (x + 0.044715f * x * x * x))); }
#define XB_TMO      128
#define XB_XCNT(j)  (256  + 64 * (j))
#define XB_XSUB(j)  (1280 + 64 * (j))
#define XB_XGEN(j)  (2304 + 64 * (j))
#define XB_TOP      3328
#define XB_TOPGEN   3392
#define XCD_BAR_WORDS 3456
#define XB_SPIN_CAP (1u << 18)

__device__ __forceinline__ unsigned xb_ld(unsigned* p)              { return __hip_atomic_load(p, __ATOMIC_RELAXED, __HIP_MEMORY_SCOPE_AGENT); }
__device__ __forceinline__ unsigned xb_add(unsigned* p, unsigned v) { return __hip_atomic_fetch_add(p, v, __ATOMIC_RELAXED, __HIP_MEMORY_SCOPE_AGENT); }
__device__ __forceinline__ unsigned xb_xcc_id() { return (unsigned)__builtin_amdgcn_s_getreg((3 << 11) | 20) & 0xFu; }
#define XB_SPIN(cond, bar) do { unsigned _sp = 0; while (cond) { __builtin_amdgcn_s_sleep(1); \
    if ((++_sp & 255u) == 0u) { if (xb_ld(&(bar)[XB_TMO])) break; if (_sp > XB_SPIN_CAP) { atomicAdd(&(bar)[XB_TMO], 1u); break; } } } } while (0)

struct XcdBarrier {
    unsigned* bar; unsigned x;
    volatile LAS unsigned* st;
};

__device__ __forceinline__ XcdBarrier xcd_barrier_post(unsigned* bar, volatile LAS unsigned* st) {
    XcdBarrier b; b.bar = bar; b.x = xb_xcc_id(); b.st = st;
    if (threadIdx.x == 0) (void)xb_add(&bar[XB_XCNT(b.x)], 1u);
    return b;
}
__device__ __forceinline__ void xcd_barrier_complete(unsigned* bar, unsigned x, unsigned& nloc, unsigned& nx) {
    const unsigned G = gridDim.x * gridDim.y * gridDim.z;
    unsigned sum, cnt, mine, sp = 0u;
    for (;;) {
        sum = 0u; cnt = 0u; mine = 0u;
#pragma unroll
        for (unsigned j = 0; j < 16; ++j) { const unsigned c = xb_ld(&bar[XB_XCNT(j)]); sum += c; cnt += (c > 0u) ? 1u : 0u; mine = (j == x) ? c : mine; }
        if (sum == G) break;
        __builtin_amdgcn_s_sleep(1);
        if ((++sp & 255u) == 0u) { if (xb_ld(&bar[XB_TMO])) break; if (sp > XB_SPIN_CAP) { atomicAdd(&bar[XB_TMO], 1u); break; } }
    }
    nloc = mine > 0u ? mine : 1u; nx = cnt > 0u ? cnt : 1u;
}

__device__ __forceinline__ void xcd_barrier(const XcdBarrier& b) {
    asm volatile("s_waitcnt vmcnt(0)" ::: "memory");
    __syncthreads();
    if (threadIdx.x == 0) {
        unsigned* bar = b.bar;
        __builtin_amdgcn_s_waitcnt(0);
        unsigned nloc = b.st[0], nx = b.st[1];
        if (nloc == 0u) { xcd_barrier_complete(bar, b.x, nloc, nx); b.st[0] = nloc; b.st[1] = nx; }
        const unsigned old = xb_add(&bar[XB_XSUB(b.x)], 1u);
        const unsigned gen = old / nloc;
        if (old + 1u == (gen + 1u) * nloc) {
            __builtin_amdgcn_fence(__ATOMIC_RELEASE, "agent");
            asm volatile("s_waitcnt vmcnt(0)" ::: "memory");
            const unsigned og = xb_add(&bar[XB_TOP], 1u);
            const unsigned tg = og / nx;
            if (og + 1u == (tg + 1u) * nx) xb_add(&bar[XB_TOPGEN], 1u);
            else XB_SPIN(xb_ld(&bar[XB_TOPGEN]) == tg, bar);
            __builtin_amdgcn_fence(__ATOMIC_ACQUIRE, "agent");
            xb_add(&bar[XB_XGEN(b.x)], 1u);
            asm volatile("s_waitcnt vmcnt(0)" ::: "memory");
        } else {
            XB_SPIN(xb_ld(&bar[XB_XGEN(b.x)]) == gen, bar);
            __builtin_amdgcn_fence(__ATOMIC_ACQUIRE, "agent");
            asm volatile("s_waitcnt vmcnt(0)" ::: "memory");
        }
    }
    __syncthreads();
}

constexpr int RG_XS = 144;
constexpr int RG_WAVE_LDS = 64 * RG_XS;
constexpr int RG_HIN_OFF = 8 * RG_WAVE_LDS;
struct RgParams { const bf16* P; const float* conv_w; const float* conv_b; const bf16* RGW; const float* ba; const float* bx; const float* lam; float* RGS; bf16* Y; };

__device__ __forceinline__ float sigmoid_fast(float x) { return __builtin_amdgcn_rcpf(1.0f + __builtin_amdgcn_exp2f(-1.4426950408889634f * x)); }

template <int PASS>
__device__ __forceinline__ void rg_unit(const RgParams& p, LAS unsigned char* lds, int b, int n, int tid) {
    const int wave = __builtin_amdgcn_readfirstlane(tid >> 6), lane = tid & 63, blk = wave;
    const int j = lane & 15, q = lane >> 4;
    LAS unsigned char* xs = lds + wave * RG_WAVE_LDS;
    const int t0 = n * 64;
    const size_t rowb = (size_t)b * SEQ;
    if (PASS == 3) {
        LAS float* hin = (LAS float*)(lds + RG_HIN_OFF);
        const int c = tid;
        const float2* S0 = (const float2*)p.RGS + ((size_t)(b * 128) * 2 + 0) * 512 + c;
        float h = 0.f;
#pragma unroll 8
        for (int m = 0; m < n; ++m) { const float2 s = S0[(size_t)m * 1024]; h = s.x * h + s.y; }
        hin[c] = h;
        h = 0.f;
#pragma unroll 8
        for (int m = 127; m > n; --m) { const float2 s = S0[(size_t)m * 1024 + 512]; h = s.x * h + s.y; }
        hin[512 + c] = h;
    }
    {
        const int cp = lane & 31, tp = lane >> 5, c = blk * 64 + 2 * cp;
        float w0[4], w1[4];
#pragma unroll
        for (int t = 0; t < 4; ++t) { w0[t] = p.conv_w[t * 512 + c]; w1[t] = p.conv_w[t * 512 + c + 1]; }
        const float cb0 = p.conv_b[c], cb1 = p.conv_b[c + 1];
        const bf16* src = p.P + rowb * NP + c;
        auto ld = [&](int t) -> unsigned { return (t >= 0 && t < SEQ) ? *(const unsigned*)(src + (size_t)t * NP) : 0u; };
        unsigned r0 = ld(t0 + tp - 2), r1 = ld(t0 + tp - 1);
#pragma unroll 4
        for (int tt = 0; tt < 32; ++tt) {
            const int tk = 2 * tt + tp;
            const unsigned r2 = ld(t0 + tk), r3 = ld(t0 + tk + 1);
            const float x0 = cb0 + w0[0] * bf2f((bf16)(r0 & 0xffff)) + w0[1] * bf2f((bf16)(r1 & 0xffff)) + w0[2] * bf2f((bf16)(r2 & 0xffff)) + w0[3] * bf2f((bf16)(r3 & 0xffff));
            const float x1 = cb1 + w1[0] * bf2f((bf16)(r0 >> 16)) + w1[1] * bf2f((bf16)(r1 >> 16)) + w1[2] * bf2f((bf16)(r2 >> 16)) + w1[3] * bf2f((bf16)(r3 >> 16));
            *(LAS unsigned*)(xs + tk * RG_XS + 4 * cp) = pk2(x0, x1);
            r0 = r2; r1 = r3;
        }
    }
    __syncthreads();
#pragma unroll 1
    for (int nt = 0; nt < 4; ++nt) {
        const int c = blk * 64 + 16 * nt + j;
        float h0v[4][4];
#pragma unroll
        for (int d = 0; d < 2; ++d) {
            bf16x8 Bf[2][2];
#pragma unroll
            for (int g = 0; g < 2; ++g)
#pragma unroll
                for (int ks = 0; ks < 2; ++ks) Bf[g][ks] = *(const bf16x8*)(p.RGW + ((size_t)((d * 2 + g) * 8 + blk) * 64 + 16 * nt + j) * 64 + 32 * ks + 8 * q);
            const float bav = p.ba[d * 512 + c], bxv = p.bx[d * 512 + c], spv = 16.0f * log1pf(expf(-p.lam[d * 512 + c]));
            float hinv = (PASS == 3) ? ((LAS float*)(lds + RG_HIN_OFF))[d * 512 + c] : 0.f, CA = 1.f, CH = 0.f;
#pragma unroll
            for (int ti = 0; ti < 4; ++ti) {
                const int tile = d == 0 ? ti : 3 - ti;
                f32x4 pr = (f32x4){0.f, 0.f, 0.f, 0.f}, pi = (f32x4){0.f, 0.f, 0.f, 0.f};
#pragma unroll
                for (int ks = 0; ks < 2; ++ks) { const bf16x8 Af = *(const LAS bf16x8*)(xs + (16 * tile + j) * RG_XS + 64 * ks + 16 * q);
                    pr = __builtin_amdgcn_mfma_f32_16x16x32_bf16(Af, Bf[0][ks], pr, 0, 0, 0); pi = __builtin_amdgcn_mfma_f32_16x16x32_bf16(Af, Bf[1][ks], pi, 0, 0, 0); }
                float a[4], bb[4];
#pragma unroll
                for (int r = 0; r < 4; ++r) {
                    const float x = bf2f(*(const LAS bf16*)(xs + (16 * tile + 4 * q + r) * RG_XS + 2 * (16 * nt + j)));
                    const float rr = sigmoid_fast(pr[r] + bav), ii = sigmoid_fast(pi[r] + bxv);
                    const float z = spv * rr;
                    a[r] = __builtin_amdgcn_exp2f(-0.7213475204444817f * z);
                    const float om = z * (1.f - z * 0.5f * (1.f - z * (1.f / 3.f) * (1.f - z * 0.25f * (1.f - z * 0.2f * (1.f - z * (1.f / 6.f))))));
                    bb[r] = __builtin_amdgcn_sqrtf(om) * ii * x;
                }
                float L[4], Pc[4];
                if (d == 0) { L[0] = bb[0]; Pc[0] = a[0];
#pragma unroll
                    for (int r = 1; r < 4; ++r) { L[r] = a[r] * L[r - 1] + bb[r]; Pc[r] = a[r] * Pc[r - 1]; } }
                else { L[3] = bb[3]; Pc[3] = a[3];
#pragma unroll
                    for (int r = 2; r >= 0; --r) { L[r] = a[r] * L[r + 1] + bb[r]; Pc[r] = a[r] * Pc[r + 1]; } }
                float IA = d == 0 ? Pc[3] : Pc[0], IH = d == 0 ? L[3] : L[0];
                { const float A1 = d == 0 ? __shfl_up(IA, 16) : __shfl_down(IA, 16), H1 = d == 0 ? __shfl_up(IH, 16) : __shfl_down(IH, 16);
                  const bool ok = d == 0 ? (q >= 1) : (q <= 2); if (ok) { IH = IA * H1 + IH; IA = IA * A1; } }
                { const float A2 = d == 0 ? __shfl_up(IA, 32) : __shfl_down(IA, 32), H2 = d == 0 ? __shfl_up(IH, 32) : __shfl_down(IH, 32);
                  const bool ok = d == 0 ? (q >= 2) : (q <= 1); if (ok) { IH = IA * H2 + IH; IA = IA * A2; } }
                float EA = d == 0 ? __shfl_up(IA, 16) : __shfl_down(IA, 16), EH = d == 0 ? __shfl_up(IH, 16) : __shfl_down(IH, 16);
                if (d == 0 ? (q == 0) : (q == 3)) { EA = 1.f; EH = 0.f; }
                const float TA = __shfl(IA, d == 0 ? 48 + j : j), TH = __shfl(IH, d == 0 ? 48 + j : j);
                if (PASS == 1) { CH = TA * CH + TH; CA = TA * CA; }
                else {
                    const float hl = EH + EA * hinv;
#pragma unroll
                    for (int r = 0; r < 4; ++r) { const float h = L[r] + Pc[r] * hl;
                        if (d == 0) h0v[tile][r] = h;
                        else {
                            const size_t row = rowb + t0 + 16 * tile + 4 * q + r;
                            const float gt = bf2f(p.P[row * NP + 512 + c]);
                            const float uu = 0.7978845608028654f * (gt + 0.044715f * gt * gt * gt);
                            const float ge = gt * __builtin_amdgcn_rcpf(1.0f + __builtin_amdgcn_exp2f(-2.8853900817779268f * uu));
                            p.Y[row * D + c] = (bf16)f2bf((h0v[tile][r] + h) * ge);
                        } }
                    hinv = TH + TA * hinv;
                }
            }
            if (PASS == 1 && q == 0) ((float2*)p.RGS)[((size_t)(b * 128 + n) * 2 + d) * 512 + c] = make_float2(CA, CH);
        }
    }
    __syncthreads();
}


typedef __bf16 bf16x2_t __attribute__((ext_vector_type(2)));
typedef float f32x2_t __attribute__((ext_vector_type(2)));
typedef unsigned u32x2 __attribute__((ext_vector_type(2)));
__device__ __forceinline__ unsigned pkbf(float a, float b) { f32x2_t v = {a, b}; bf16x2_t r = __builtin_convertvector(v, bf16x2_t); return __builtin_bit_cast(unsigned, r); }
__device__ __forceinline__ bf16x8 pack_tiles(const f32x4& t0, const f32x4& t1) { v4u w; w.x = pkbf(t0[0], t0[1]); w.y = pkbf(t0[2], t0[3]); w.z = pkbf(t1[0], t1[1]); w.w = pkbf(t1[2], t1[3]); return __builtin_bit_cast(bf16x8, w); }
__device__ __forceinline__ bf16x8 ldA_perm(const LAS unsigned char* rowp, int kb, int q) {
    const u32x2 a = *(const LAS u32x2*)(rowp + 64 * kb + 8 * q), c = *(const LAS u32x2*)(rowp + 64 * kb + 32 + 8 * q);
    v4u w; w.x = a.x; w.y = a.y; w.z = c.x; w.w = c.y; return __builtin_bit_cast(bf16x8, w);
}
__device__ __forceinline__ bf16x8 ldA_perm_f32(const LAS unsigned char* rowp, int kb, int q) {
    const f32x4 a = *(const LAS f32x4*)(rowp + 128 * kb + 16 * q), c = *(const LAS f32x4*)(rowp + 128 * kb + 64 + 16 * q);
    return pack_tiles(a, c);
}
constexpr int G_ST = 272, G_ST2 = 144;
constexpr int G_QN = 0, G_KN = 17408, G_VV = 34816, G_WQ = 52224, G_LM = 69632, G_KDT = 87040, G_ATT = 105472, G_TD = 114688, G_GT = 118784, G_LDS_END = 120832;
constexpr int GT_BETA = 0, GT_GC = 256, GT_EGC = 512, GT_EKD = 768, GT_CD = 1024;
struct GdnParams { const bf16* P; const float* BA; const float* conv_w; const float* a_log; const float* dt_bias; };

__device__ __forceinline__ void gdn_prep(const GdnParams& p, LAS unsigned char* lds, int b, int h, int ntok, int d, int tid, f32x4 (&u)[4]) {
    const int wave = __builtin_amdgcn_readfirstlane(tid >> 6), lane = tid & 63, fr = lane & 15, q = lane >> 4;
    const int t0 = ntok * 64; const size_t rowb = (size_t)b * SEQ;
    LAS float* GT = (LAS float*)(lds + G_GT);
    if (wave == 0) {
        const int i = lane, t = t0 + (d ? 63 - i : i);
        const float* bar = p.BA + (rowb + t) * 16;
        const float be = 1.f / (1.f + expf(-bar[d * 4 + h]));
        const float x = bar[8 + d * 4 + h] + p.dt_bias[d * 4 + h];
        const float sp = x > 20.f ? x : log1pf(expf(x));
        float gc = -expf(p.a_log[d * 4 + h]) * sp;
#pragma unroll
        for (int o = 1; o < 64; o <<= 1) { const float v = __shfl_up(gc, o); if (lane >= o) gc += v; }
        const float glast = __shfl(gc, 63);
        GT[GT_BETA / 4 + i] = be; GT[GT_GC / 4 + i] = gc; GT[GT_EGC / 4 + i] = expf(gc); GT[GT_EKD / 4 + i] = expf(glast - gc);
        if (i == 0) GT[GT_CD / 4] = expf(glast);
    }
    {
        const int tk = tid >> 3, cg = tid & 7, t = t0 + tk;
#pragma unroll 1
        for (int which = 0; which < 3; ++which) {
            const int cbase = which * 512 + h * 128 + cg * 16;
            float acc[16];
#pragma unroll
            for (int e = 0; e < 16; ++e) acc[e] = 0.f;
#pragma unroll
            for (int tap = 0; tap < 4; ++tap) {
                const int ts = t + tap - 2;
                if (ts >= 0 && ts < SEQ) {
                    const bf16* src = p.P + (rowb + ts) * NP + 1024 + cbase;
                    const v4u r0 = *(const v4u*)src, r1 = *(const v4u*)(src + 8);
                    const float* wp = p.conv_w + tap * 1536 + cbase;
                    const f32x4 w0 = *(const f32x4*)wp, w1 = *(const f32x4*)(wp + 4), w2 = *(const f32x4*)(wp + 8), w3 = *(const f32x4*)(wp + 12);
                    const unsigned rr[8] = {r0.x, r0.y, r0.z, r0.w, r1.x, r1.y, r1.z, r1.w};
                    const float ww[16] = {w0[0], w0[1], w0[2], w0[3], w1[0], w1[1], w1[2], w1[3], w2[0], w2[1], w2[2], w2[3], w3[0], w3[1], w3[2], w3[3]};
#pragma unroll
                    for (int e = 0; e < 8; ++e) { acc[2 * e] += ww[2 * e] * __uint_as_float(rr[e] << 16); acc[2 * e + 1] += ww[2 * e + 1] * __uint_as_float(rr[e] & 0xffff0000u); }
                }
            }
            float ss = 0.f;
#pragma unroll
            for (int e = 0; e < 16; ++e) { acc[e] = acc[e] / (1.f + expf(-acc[e])); ss += acc[e] * acc[e]; }
            if (which < 2) {
                ss += __shfl_xor(ss, 1); ss += __shfl_xor(ss, 2); ss += __shfl_xor(ss, 4);
                const float rs = rsqrtf(ss + EPS) * (which == 0 ? 0.08838834764831845f : 1.0f);
#pragma unroll
                for (int e = 0; e < 16; ++e) acc[e] *= rs;
            }
            LAS unsigned char* dst = lds + (which == 0 ? G_QN : which == 1 ? G_KN : G_VV) + tk * G_ST + cg * 32;
            v4u o0, o1;
            o0.x = pkbf(acc[0], acc[1]); o0.y = pkbf(acc[2], acc[3]); o0.z = pkbf(acc[4], acc[5]); o0.w = pkbf(acc[6], acc[7]);
            o1.x = pkbf(acc[8], acc[9]); o1.y = pkbf(acc[10], acc[11]); o1.z = pkbf(acc[12], acc[13]); o1.w = pkbf(acc[14], acc[15]);
            *(LAS v4u*)dst = o0; *(LAS v4u*)(dst + 16) = o1;
        }
    }
    __syncthreads();
    {
        const int mx = wave >> 2, mt = wave & 3;
        const int arow = mx == 0 ? (d ? 63 - (16 * mt + fr) : 16 * mt + fr) : 16 * mt + fr;
        const LAS unsigned char* abase = lds + (mx == 0 ? G_KN : G_QN) + arow * G_ST + 16 * q;
        bf16x8 af[4];
#pragma unroll
        for (int kb = 0; kb < 4; ++kb) af[kb] = *(const LAS bf16x8*)(abase + 64 * kb);
#pragma unroll
        for (int nt = 0; nt < 4; ++nt) {
            const int j = 16 * nt + fr, brow = d ? 63 - j : j;
            f32x4 c = (f32x4){0.f, 0.f, 0.f, 0.f};
#pragma unroll
            for (int kb = 0; kb < 4; ++kb) c = __builtin_amdgcn_mfma_f32_16x16x32_bf16(af[kb], *(const LAS bf16x8*)(lds + G_KN + brow * G_ST + 16 * q + 64 * kb), c, 0, 0, 0);
            const float gcj = GT[GT_GC / 4 + j];
#pragma unroll
            for (int r = 0; r < 4; ++r) {
                const int i = 16 * mt + 4 * q + r;
                if (mx == 0) { const float val = (i > j) ? -GT[GT_BETA / 4 + i] * c[r] * expf(GT[GT_GC / 4 + i] - gcj) : 0.f; *(LAS float*)(lds + G_LM + i * G_ST + 4 * j) = val; }
                else { const int pi = d ? 63 - i : i; const float val = (pi >= j) ? c[r] * expf(GT[GT_GC / 4 + pi] - gcj) : 0.f; *(LAS bf16*)(lds + G_ATT + i * G_ST2 + 2 * j) = (bf16)f2bf(val); }
            }
        }
    }
    {
        const int j = tid & 63, cgp = tid >> 6, trow = d ? 63 - j : j; const float e = GT[GT_EKD / 4 + j];
        const LAS unsigned char* src = lds + G_KN + trow * G_ST + cgp * 32;
        const v4u r0 = *(const LAS v4u*)src, r1 = *(const LAS v4u*)(src + 16);
        const unsigned rr[8] = {r0.x, r0.y, r0.z, r0.w, r1.x, r1.y, r1.z, r1.w};
#pragma unroll
        for (int e2 = 0; e2 < 8; ++e2) {
            *(LAS bf16*)(lds + G_KDT + (16 * cgp + 2 * e2) * G_ST2 + 2 * j) = (bf16)f2bf(__uint_as_float(rr[e2] << 16) * e);
            *(LAS bf16*)(lds + G_KDT + (16 * cgp + 2 * e2 + 1) * G_ST2 + 2 * j) = (bf16)f2bf(__uint_as_float(rr[e2] & 0xffff0000u) * e);
        }
    }
    __syncthreads();
    if (wave == 0) {
        const int bk = lane >> 4, c = lane & 15; float T[16];
#pragma unroll
        for (int r = 0; r < 16; ++r) { float a = (r == c) ? 1.f : 0.f;
#pragma unroll
            for (int m = 0; m < r; ++m) a += *(const LAS float*)(lds + G_LM + (16 * bk + r) * G_ST + 4 * (16 * bk + m)) * T[m];
            T[r] = a; }
#pragma unroll
        for (int r = 0; r < 16; ++r) *(LAS float*)(lds + G_TD + ((bk * 16 + r) * 16 + c) * 4) = T[r];
    }
    __syncthreads();
    {
        const int col = 16 * wave + fr;
        f32x4 X[2][4];
#pragma unroll
        for (int bi = 0; bi < 4; ++bi)
#pragma unroll
            for (int r = 0; r < 4; ++r) { const int i = 16 * bi + 4 * q + r, trow = d ? 63 - i : i; const float be = GT[GT_BETA / 4 + i];
                X[0][bi][r] = be * bf2f(*(const LAS bf16*)(lds + G_VV + trow * G_ST + 2 * col));
                X[1][bi][r] = -be * GT[GT_EGC / 4 + i] * bf2f(*(const LAS bf16*)(lds + G_KN + trow * G_ST + 2 * col)); }
        const f32x4 zero = (f32x4){0.f, 0.f, 0.f, 0.f};
#pragma unroll
        for (int x = 0; x < 2; ++x)
#pragma unroll
            for (int bi = 0; bi < 4; ++bi) {
                f32x4 acc = X[x][bi];
                if (bi >= 1) acc = __builtin_amdgcn_mfma_f32_16x16x32_bf16(ldA_perm_f32(lds + G_LM + (16 * bi + fr) * G_ST, 0, q), pack_tiles(X[x][0], bi >= 2 ? X[x][1] : zero), acc, 0, 0, 0);
                if (bi == 3) acc = __builtin_amdgcn_mfma_f32_16x16x32_bf16(ldA_perm_f32(lds + G_LM + (48 + fr) * G_ST, 1, q), pack_tiles(X[x][2], zero), acc, 0, 0, 0);
                const f32x4 td = *(const LAS f32x4*)(lds + G_TD + ((bi * 16 + fr) * 16 + 4 * q) * 4);
                X[x][bi] = __builtin_amdgcn_mfma_f32_16x16x32_bf16(pack_tiles(td, zero), pack_tiles(acc, zero), zero, 0, 0, 0);
            }
#pragma unroll
        for (int bi = 0; bi < 4; ++bi) { u[bi] = X[0][bi];
#pragma unroll
            for (int r = 0; r < 4; ++r) *(LAS bf16*)(lds + G_WQ + (16 * bi + 4 * q + r) * G_ST + 2 * col) = (bf16)f2bf(X[1][bi][r]); }
    }
    __syncthreads();
}

template <bool WITH_O>
__device__ __forceinline__ void gdn_step(const LAS unsigned char* lds, int d, int lane, f32x4 (&S)[8], const f32x4 (&u)[4], f32x4 (&o)[4]) {
    const int fr = lane & 15, q = lane >> 4;
    const LAS float* GT = (const LAS float*)(lds + G_GT);
    bf16x8 Sb[4];
#pragma unroll
    for (int kb = 0; kb < 4; ++kb) Sb[kb] = pack_tiles(S[2 * kb], S[2 * kb + 1]);
    f32x4 vn[4], o1[4];
#pragma unroll
    for (int mt = 0; mt < 4; ++mt) { vn[mt] = u[mt]; o1[mt] = (f32x4){0.f, 0.f, 0.f, 0.f}; }
#pragma unroll
    for (int mt = 0; mt < 4; ++mt) { asm volatile("" ::: "memory");
#pragma unroll
        for (int kb = 0; kb < 4; ++kb) {
            vn[mt] = __builtin_amdgcn_mfma_f32_16x16x32_bf16(ldA_perm(lds + G_WQ + (16 * mt + fr) * G_ST, kb, q), Sb[kb], vn[mt], 0, 0, 0);
            if (WITH_O) o1[mt] = __builtin_amdgcn_mfma_f32_16x16x32_bf16(ldA_perm(lds + G_QN + (16 * mt + fr) * G_ST, kb, q), Sb[kb], o1[mt], 0, 0, 0);
        } }
    bf16x8 vb[2];
#pragma unroll
    for (int kb = 0; kb < 2; ++kb) vb[kb] = pack_tiles(vn[2 * kb], vn[2 * kb + 1]);
    const float cd = GT[GT_CD / 4];
#pragma unroll
    for (int mt = 0; mt < 8; ++mt) { if ((mt & 1) == 0) asm volatile("" ::: "memory"); S[mt] = S[mt] * cd;
#pragma unroll
        for (int kb = 0; kb < 2; ++kb) S[mt] = __builtin_amdgcn_mfma_f32_16x16x32_bf16(ldA_perm(lds + G_KDT + (16 * mt + fr) * G_ST2, kb, q), vb[kb], S[mt], 0, 0, 0); }
    if (WITH_O)
#pragma unroll
    for (int mt = 0; mt < 4; ++mt) { f32x4 o2 = (f32x4){0.f, 0.f, 0.f, 0.f};
#pragma unroll
        for (int kb = 0; kb < 2; ++kb) o2 = __builtin_amdgcn_mfma_f32_16x16x32_bf16(ldA_perm(lds + G_ATT + (16 * mt + fr) * G_ST2, kb, q), vb[kb], o2, 0, 0, 0);
#pragma unroll
        for (int r = 0; r < 4; ++r) { const int it = 16 * mt + 4 * q + r, pi = d ? 63 - it : it; o[mt][r] = o1[mt][r] * GT[GT_EGC / 4 + pi] + o2[r]; } }
}

constexpr int G_NRM = G_LDS_END;
constexpr int G_LDS_ALL = G_LDS_END + 2048;
struct GdnWs { bf16* WQc; bf16* KTc; u32x2* UU; float* CD; u32x2* SS; float* OFs; const bf16* Pz; const float* gnorm; bf16* Y; };
__device__ __forceinline__ int gdn_inst(int d, int b, int h, int np) { return ((d * 2 + b) * 4 + h) * 128 + np; }

__device__ __forceinline__ void gdn_m1_unit(const GdnParams& p, const GdnWs& w, LAS unsigned char* lds, int unit, int tid) {
    const int np = unit & 127, h = (unit >> 7) & 3, b = (unit >> 9) & 1, d = unit >> 10;
    const int ntok = d ? 127 - np : np, lane = tid & 63, wave = __builtin_amdgcn_readfirstlane(tid >> 6);
    f32x4 u[4];
    { int tid_ = tid; asm volatile("" : "+v"(tid_)); gdn_prep(p, lds, b, h, ntok, d, tid_, u); }
    const size_t inst = (size_t)unit;
#pragma unroll
    for (int i = 0; i < 2; ++i) {
        const int ch = tid + 512 * i;
        { const int row = ch >> 4, c16 = ch & 15; *(v4u*)(w.WQc + inst * 8192 + row * 128 + c16 * 8) = *(const LAS v4u*)(lds + G_WQ + row * G_ST + c16 * 16); }
        { const int row = ch >> 3, c16 = ch & 7;  *(v4u*)(w.KTc + inst * 8192 + row * 64 + c16 * 8) = *(const LAS v4u*)(lds + G_KDT + row * G_ST2 + c16 * 16); }
    }
#pragma unroll
    for (int mt = 0; mt < 4; ++mt) { u32x2 v; v.x = pkbf(u[mt][0], u[mt][1]); v.y = pkbf(u[mt][2], u[mt][3]); w.UU[((inst * 8 + wave) * 4 + mt) * 64 + lane] = v; }
    if (tid == 0) w.CD[inst] = ((const LAS float*)(lds + G_GT))[GT_CD / 4];
    __syncthreads();
}

__device__ __forceinline__ void gdn_m2_seq(const GdnWs& w, LAS unsigned char* lds, int seq, int tid) {
    const int lane = tid & 63, wave = __builtin_amdgcn_readfirstlane(tid >> 6);
    f32x4 S[8];
#pragma unroll
    for (int i = 0; i < 8; ++i) S[i] = (f32x4){0.f, 0.f, 0.f, 0.f};
    v4u pw[2], pk[2]; u32x2 pu[4]; float pcd;
    auto issue = [&](int np) {
        const size_t inst = (size_t)seq * 128 + np;
#pragma unroll
        for (int i = 0; i < 2; ++i) { const int ch = tid + 512 * i;
            pw[i] = *(const v4u*)(w.WQc + inst * 8192 + (ch >> 4) * 128 + (ch & 15) * 8);
            pk[i] = *(const v4u*)(w.KTc + inst * 8192 + (ch >> 3) * 64 + (ch & 7) * 8); }
#pragma unroll
        for (int mt = 0; mt < 4; ++mt) pu[mt] = w.UU[((inst * 8 + wave) * 4 + mt) * 64 + lane];
        pcd = w.CD[inst];
    };
    issue(0);
    for (int np = 0; np < 128; ++np) {
#pragma unroll
        for (int i = 0; i < 2; ++i) { const int ch = tid + 512 * i;
            *(LAS v4u*)(lds + G_WQ + (ch >> 4) * G_ST + (ch & 15) * 16) = pw[i];
            *(LAS v4u*)(lds + G_KDT + (ch >> 3) * G_ST2 + (ch & 7) * 16) = pk[i]; }
        if (tid == 0) ((LAS float*)(lds + G_GT))[GT_CD / 4] = pcd;
        f32x4 u[4], o[4];
#pragma unroll
        for (int mt = 0; mt < 4; ++mt) { u[mt][0] = __uint_as_float(pu[mt].x << 16); u[mt][1] = __uint_as_float(pu[mt].x & 0xffff0000u); u[mt][2] = __uint_as_float(pu[mt].y << 16); u[mt][3] = __uint_as_float(pu[mt].y & 0xffff0000u); }
        __syncthreads();
        if (np + 1 < 128) issue(np + 1);
        if ((np & 3) == 0) {
#pragma unroll
            for (int t = 0; t < 8; ++t) { u32x2 v; v.x = pkbf(S[t][0], S[t][1]); v.y = pkbf(S[t][2], S[t][3]); w.SS[((((size_t)seq * 32 + (np >> 2)) * 8 + wave) * 8 + t) * 64 + lane] = v; }
        }
        gdn_step<false>(lds, 0, lane, S, u, o);
        __syncthreads();
    }
}

__device__ __forceinline__ void gdn_m3_unit(const GdnParams& p, const GdnWs& w, LAS unsigned char* lds, int unit, int tid) {
    const int tg = unit & 31, h = (unit >> 5) & 3, b = unit >> 7;
    const int lane = tid & 63, wave = __builtin_amdgcn_readfirstlane(tid >> 6), fr = lane & 15, q = lane >> 4;
    const int col = h * 128 + 16 * wave + fr;
    LAS float* NRM = (LAS float*)(lds + G_NRM);
#pragma unroll 1
    for (int d = 0; d < 2; ++d) {
        const int gp = d ? 31 - tg : tg, seq = (d * 2 + b) * 4 + h;
        f32x4 S[8];
#pragma unroll
        for (int t = 0; t < 8; ++t) { const u32x2 v = w.SS[((((size_t)seq * 32 + gp) * 8 + wave) * 8 + t) * 64 + lane];
            S[t][0] = __uint_as_float(v.x << 16); S[t][1] = __uint_as_float(v.x & 0xffff0000u); S[t][2] = __uint_as_float(v.y << 16); S[t][3] = __uint_as_float(v.y & 0xffff0000u); }
#pragma unroll 1
        for (int k = 0; k < 4; ++k) {
            const int np = 4 * gp + k, ntok = d ? 127 - np : np;
            f32x4 u[4], o[4];
            int tid_ = tid; asm volatile("" : "+v"(tid_));
            gdn_prep(p, lds, b, h, ntok, d, tid_, u);
            gdn_step<true>(lds, d, tid_ & 63, S, u, o);
            const size_t row0 = (size_t)b * SEQ + ntok * 64;
            if (d == 0) {
#pragma unroll
                for (int mt = 0; mt < 4; ++mt)
#pragma unroll
                    for (int r = 0; r < 4; ++r) w.OFs[(row0 + 16 * mt + 4 * q + r) * 512 + col] = o[mt][r];
                __syncthreads();
            } else {
#pragma unroll
                for (int mt = 0; mt < 4; ++mt) { asm volatile("" ::: "memory");
#pragma unroll
                    for (int r = 0; r < 4; ++r) { o[mt][r] += w.OFs[(row0 + 16 * mt + 4 * q + r) * 512 + col];
                        float ss = o[mt][r] * o[mt][r];
                        ss += __shfl_xor(ss, 1); ss += __shfl_xor(ss, 2); ss += __shfl_xor(ss, 4); ss += __shfl_xor(ss, 8);
                        if (fr == 0) NRM[(16 * mt + 4 * q + r) * 8 + wave] = ss; } }
                __syncthreads();
                const float gn = w.gnorm[16 * wave + fr];
#pragma unroll
                for (int mt = 0; mt < 4; ++mt) { asm volatile("" ::: "memory");
#pragma unroll
                    for (int r = 0; r < 4; ++r) { const int rr = 16 * mt + 4 * q + r;
                        const f32x4 a = *(const LAS f32x4*)(NRM + rr * 8), c = *(const LAS f32x4*)(NRM + rr * 8 + 4);
                        const float rs = rsqrtf(((a[0] + a[1]) + (a[2] + a[3]) + (c[0] + c[1]) + (c[2] + c[3])) * (1.f / 128.f) + EPS);
                        const float z = bf2f(w.Pz[(row0 + rr) * NP + 2560 + col]);
                        const float sz = z * __builtin_amdgcn_rcpf(1.0f + __builtin_amdgcn_exp2f(-1.4426950408889634f * z));
                        w.Y[(row0 + rr) * D + 512 + col] = (bf16)f2bf(o[mt][r] * rs * gn * sz); } }
                __syncthreads();
            }
        }
    }
}

struct Frame {
    LAS unsigned char* lds;
    volatile LAS unsigned* MISC;
    gu32* ctl;
    int tid, lane, wave, G;
};

__device__ __forceinline__ void p0_transpose_item(const float* W, int ldw, int K, bf16* WT, int drow0, int k0, int n0, LAS float* scr, int lane) {
#pragma unroll 8
    for (int i = 0; i < 32; ++i) { const int kk = 2 * i + (lane >> 5); scr[kk * 33 + (lane & 31)] = W[(size_t)(k0 + kk) * ldw + n0 + (lane & 31)]; }
    LDS_WAIT(); asm volatile("" ::: "memory");
    const int c = lane & 7;
#pragma unroll
    for (int j = 0; j < 4; ++j) { const int n = (lane >> 3) + 8 * j; const LAS float* s = scr + (8 * c) * 33 + n;
        v4u o; o.x = pk2(s[0 * 33], s[1 * 33]); o.y = pk2(s[2 * 33], s[3 * 33]); o.z = pk2(s[4 * 33], s[5 * 33]); o.w = pk2(s[6 * 33], s[7 * 33]);
        *(GAS v4u*)(WT + (size_t)(drow0 + n) * K + k0 + 8 * c) = o; }
    LDS_WAIT(); asm volatile("" ::: "memory");
}
__device__ __forceinline__ void rms_row_to_bf16(const float* xrow, const float* g, bf16* orow, int lane) {
    const GAS f32x4* xr = (const GAS f32x4*)xrow + lane;
    f32x4 v[4]; float s = 0.f;
#pragma unroll
    for (int j = 0; j < 4; ++j) { v[j] = xr[64 * j]; s += (v[j].x * v[j].x + v[j].y * v[j].y) + (v[j].z * v[j].z + v[j].w * v[j].w); }
    const float rstd = rsqrtf(wave_sum(s) * (1.f / D) + EPS);
    GAS unsigned long long* o8 = (GAS unsigned long long*)orow + lane;
#pragma unroll
    for (int j = 0; j < 4; ++j) { const f32x4 gv = ((const GAS f32x4*)g)[lane + 64 * j]; const f32x4 y = v[j] * rstd * gv;
        o8[64 * j] = (unsigned long long)pk2(y.x, y.y) | ((unsigned long long)pk2(y.z, y.w) << 32); }
}
__device__ __forceinline__ void rms_row_inplace(float* xrow, const float* g, int lane) {
    GAS f32x4* xr = (GAS f32x4*)xrow + lane;
    f32x4 v[4]; float s = 0.f;
#pragma unroll
    for (int j = 0; j < 4; ++j) { v[j] = xr[64 * j]; s += (v[j].x * v[j].x + v[j].y * v[j].y) + (v[j].z * v[j].z + v[j].w * v[j].w); }
    const float rstd = rsqrtf(wave_sum(s) * (1.f / D) + EPS);
#pragma unroll
    for (int j = 0; j < 4; ++j) { const f32x4 gv = ((const GAS f32x4*)g)[lane + 64 * j]; xr[64 * j] = v[j] * rstd * gv; }
}

struct Args { const float* in[24]; float* out; unsigned char* ws; int ph_lo, ph_hi; };

__device__ __forceinline__ void p0_prologue(Frame& F, const Args& args) {
    LAS float* scr = (LAS float*)(F.lds + RING_OFF + F.wave * 16384);
    unsigned char* ws = args.ws;
    const int gw = blockIdx.x * NWAVES + F.wave, NGW = F.G * NWAVES;
    constexpr int I_GU = (D / 64) * (DFF / 32);
    constexpr int I_DN = (DFF / 64) * (D / 32);
    constexpr int I_IN = (D / 64) * (NP / 32);
    constexpr int I_OUT = (D / 64) * (D / 32);
    constexpr int NITEMS = 4 * I_GU + 2 * I_DN + I_IN + I_OUT;
    for (int it = gw; it < NITEMS; it += NGW) {
        int r = it;
        if (r < 4 * I_GU) {
            const int which = r / I_GU; r -= which * I_GU;
            const float* W = args.in[which == 0 ? 2 : which == 1 ? 3 : which == 2 ? 20 : 21];
            bf16* WT = (bf16*)(ws + (which < 2 ? WS_WGU1 : WS_WGU2));
            const int nblk = DFF / 32, kb = r / nblk, nb = r % nblk, n0 = nb * 32;
            const int drow0 = (n0 >> 7) * 256 + (n0 & 127) + ((which & 1) ? 128 : 0);
            p0_transpose_item(W, DFF, D, WT, drow0, kb * 64, n0, scr, F.lane); continue;
        }
        r -= 4 * I_GU;
        if (r < 2 * I_DN) {
            const int which = r / I_DN; r -= which * I_DN;
            const float* W = args.in[which == 0 ? 4 : 22];
            bf16* WT = (bf16*)(ws + (which == 0 ? WS_WD1 : WS_WD2));
            const int nblk = D / 32, kb = r / nblk, nb = r % nblk;
            p0_transpose_item(W, D, DFF, WT, nb * 32, kb * 64, nb * 32, scr, F.lane); continue;
        }
        r -= 2 * I_DN;
        if (r < I_IN) { const int nblk = NP / 32, kb = r / nblk, nb = r % nblk;
            p0_transpose_item(args.in[6], DIN, D, (bf16*)(ws + WS_WIN), nb * 32, kb * 64, nb * 32, scr, F.lane); continue; }
        r -= I_IN;
        { const int nblk = D / 32, kb = r / nblk, nb = r % nblk;
          p0_transpose_item(args.in[7], D, D, (bf16*)(ws + WS_WOUT), nb * 32, kb * 64, nb * 32, scr, F.lane); }
    }
    { const int gt = blockIdx.x * (NWAVES * 64) + F.tid;
      if (gt < 16 * D) { const int j = gt >> 10, k = gt & 1023; ((bf16*)(ws + WS_WBA))[gt] = (bf16)f2bf(args.in[6][(size_t)k * DIN + NP + j]); } }
    { const int gt = blockIdx.x * (NWAVES * 64) + F.tid;
      if (gt < 32 * 64 * 64) { const int m = gt >> 12, jj = (gt >> 6) & 63, ii = gt & 63, d = m >> 4, g = (m >> 3) & 1, blk = m & 7;
          ((bf16*)(ws + WS_RGW))[gt] = (bf16)f2bf(args.in[g == 0 ? 10 : 12][((size_t)(d * 8 + blk) * 64 + ii) * 64 + jj]); } }
    for (int m = gw; m < M; m += NGW) rms_row_to_bf16(args.in[0] + (size_t)m * D, args.in[1], (bf16*)(ws + WS_XN) + (size_t)m * D, F.lane);
}

__device__ __forceinline__ void ba_tile(const bf16* XN, const bf16* Wba, const float* ssq, float* BA, int row0, int lane) {
    const int fr = lane & 15, fq = lane >> 4;
    f32x4 acc = (f32x4){0.f, 0.f, 0.f, 0.f};
    const bf16* ap = XN + (size_t)(row0 + fr) * D + fq * 8;
    const bf16* bp = Wba + (size_t)fr * D + fq * 8;
#pragma unroll 8
    for (int ks = 0; ks < D / 32; ++ks) {
        const bf16x8 a = *(const bf16x8*)(ap + ks * 32), b = *(const bf16x8*)(bp + ks * 32);
        acc = __builtin_amdgcn_mfma_f32_16x16x32_bf16(a, b, acc, 0, 0, 0);
    }
#pragma unroll
    for (int r = 0; r < 4; ++r) { const int row = row0 + 4 * fq + r; BA[(size_t)row * 16 + fr] = acc[r] * pg8::row_rstd(ssq, row); }
}

enum { PH_PRO = 0, PH_G1 = 1, PH_G2 = 2, PH_G3 = 3, PH_M1 = 4, PH_M2 = 5, PH_M3 = 6, PH_G4 = 7, PH_G5 = 8, PH_G6 = 9, PH_FIN = 10, PH_END = 11 };

__global__ void __launch_bounds__(NWAVES * 64, 2) mk_fwd(Args args) {
    extern __shared__ __attribute__((aligned(16))) unsigned char lds[];
    Frame F;
    F.lds = (LAS unsigned char*)lds;
    F.MISC = (volatile LAS unsigned*)(F.lds + MISC_OFF);
    F.tid = threadIdx.x; F.lane = F.tid & 63; F.wave = __builtin_amdgcn_readfirstlane(F.tid >> 6);
    F.G = gridDim.x;
    unsigned char* ws = args.ws;
    F.ctl = (gu32*)(ws + WS_CTL);
    for (int u = F.tid; u < (LDS_BYTES - LDSCTL_OFF) / 4; u += NWAVES * 64) ((LAS unsigned*)(F.lds + LDSCTL_OFF))[u] = 0u;
    __syncthreads();
    const int lo = args.ph_lo, hi = args.ph_hi;
    const bool multi = (hi - lo) > 1;
    XcdBarrier bar; bar.bar = (unsigned*)(F.ctl + CW_BAR); bar.x = 0; bar.st = nullptr;
    if (multi) bar = xcd_barrier_post((unsigned*)(F.ctl + CW_BAR), F.MISC + 8);
#define IN(k) (lo <= (k) && (k) < hi)
#define SEAM(k) do { if (IN((k) + 1)) xcd_barrier(bar); } while (0)

    float* out = args.out;
    bf16* XN = (bf16*)(ws + WS_XN); bf16* Pb = (bf16*)(ws + WS_P); bf16* H = Pb;
    float* SSQ = (float*)(ws + WS_SSQ); float* BA = (float*)(ws + WS_BA); bf16* XN3 = (bf16*)(ws + WS_XN3);

    if (IN(PH_PRO)) { p0_prologue(F, args); SEAM(PH_PRO); }

    if (IN(PH_G1)) {
        pg8::Gemm g{XN, (const bf16*)(ws + WS_WGU1), M, NGU, D}; pg8::StaticOrder S; S.init(M, NGU, F.G, (int)blockIdx.x);
        pg8::EpiSwiGLU E{H, DFF, nullptr};
        pg8::gemm_phase<pg8::EpiSwiGLU, pg8::StaticOrder, true, true>(F.lds + RING_OFF, g, S, E);
        SEAM(PH_G1);
    }
    if (IN(PH_G2)) {
        pg8::Gemm g{H, (const bf16*)(ws + WS_WD1), M, D, DFF}; pg8::StaticOrder S; S.init(M, D, F.G, (int)blockIdx.x);
        pg8::EpiResid E{args.in[0], out, D, 0.5f, args.in[5], XN, SSQ};
        pg8::gemm_phase<pg8::EpiResid, pg8::StaticOrder, true, true>(F.lds + RING_OFF, g, S, E);
        SEAM(PH_G2);
    }
    if (IN(PH_G3)) {
        pg8::Gemm g{XN, (const bf16*)(ws + WS_WIN), M, NP, D}; pg8::StaticOrder S; S.init(M, NP, F.G, (int)blockIdx.x);
        pg8::EpiScaleBf16 E{Pb, NP, SSQ};
        pg8::gemm_phase<pg8::EpiScaleBf16, pg8::StaticOrder, true, true>(F.lds + RING_OFF, g, S, E);
        for (int rt = blockIdx.x * NWAVES + F.wave; rt < M / 16; rt += F.G * NWAVES) ba_tile(XN, (const bf16*)(ws + WS_WBA), SSQ, BA, rt * 16, F.lane);
        SEAM(PH_G3);
    }
    {
        const GdnParams gp{Pb, BA, args.in[15], args.in[16], args.in[17]};
        const GdnWs gw{(bf16*)(ws + WS_WQC), (bf16*)(ws + WS_KTC), (u32x2*)(ws + WS_UU), (float*)(ws + WS_CD), (u32x2*)(ws + WS_SS), (float*)(ws + WS_WQC), Pb, args.in[18], XN};
        const RgParams rp{Pb, args.in[8], args.in[9], (const bf16*)(ws + WS_RGW), args.in[11], args.in[13], args.in[14], (float*)(ws + WS_RGS), XN};
        if (IN(PH_M1)) {
#ifndef NO_M1
            for (int unit = blockIdx.x; unit < 2048; unit += F.G) gdn_m1_unit(gp, gw, F.lds, unit, F.tid);
#endif
            SEAM(PH_M1);
        }
        if (IN(PH_M2)) {
#ifndef NO_M2
            if (blockIdx.x < 16) gdn_m2_seq(gw, F.lds, (int)blockIdx.x, F.tid);
            else
#endif
            for (int u = blockIdx.x - 16; u < 256; u += F.G - 16) rg_unit<1>(rp, F.lds, u >> 7, u & 127, F.tid);
            SEAM(PH_M2);
        }
        if (IN(PH_M3)) {
#ifndef NO_RG3
            for (int u = blockIdx.x; u < 256; u += F.G) rg_unit<3>(rp, F.lds, u >> 7, u & 127, F.tid);
#endif
#ifndef NO_M3
            for (int unit = blockIdx.x; unit < 256; unit += F.G) gdn_m3_unit(gp, gw, F.lds, unit, F.tid);
#endif
            SEAM(PH_M3);
        }
    }
    if (IN(PH_G4)) {
        pg8::Gemm g{XN, (const bf16*)(ws + WS_WOUT), M, D, D}; pg8::StaticOrder S; S.init(M, D, F.G, (int)blockIdx.x);
        pg8::EpiResid E{out, out, D, 1.0f, args.in[19], XN3, SSQ};
        pg8::gemm_phase<pg8::EpiResid, pg8::StaticOrder, true, true>(F.lds + RING_OFF, g, S, E);
        SEAM(PH_G4);
    }
    if (IN(PH_G5)) {
        pg8::Gemm g{XN3, (const bf16*)(ws + WS_WGU2), M, NGU, D}; pg8::StaticOrder S; S.init(M, NGU, F.G, (int)blockIdx.x);
        pg8::EpiSwiGLU E{H, DFF, SSQ};
        pg8::gemm_phase<pg8::EpiSwiGLU, pg8::StaticOrder, true, true>(F.lds + RING_OFF, g, S, E);
        SEAM(PH_G5);
    }
    if (IN(PH_G6)) {
        pg8::Gemm g{H, (const bf16*)(ws + WS_WD2), M, D, DFF}; pg8::StaticOrder S; S.init(M, D, F.G, (int)blockIdx.x);
        pg8::EpiResid E{out, out, D, 0.5f, nullptr, nullptr, SSQ};
        pg8::gemm_phase<pg8::EpiResid, pg8::StaticOrder, true, true>(F.lds + RING_OFF, g, S, E);
        SEAM(PH_G6);
    }
    if (IN(PH_FIN)) {
        for (int m = blockIdx.x * NWAVES + F.wave; m < M; m += F.G * NWAVES) rms_row_inplace(out + (size_t)m * D, args.in[23], F.lane);
    }
#undef IN
#undef SEAM
}

extern "C" void kernel_launch(void* const* d_in, const int* in_sizes, int n_in, void* d_out, int out_size, void* d_ws, size_t ws_size, hipStream_t stream) {
    static int grid = 0;
    if (grid == 0) {
        if (n_in != 24 || in_sizes[0] != M * D || out_size != M * D || ws_size < WS_END) { fprintf(stderr, "kernel_launch: unexpected shapes (n_in %d, out %d, ws %zu); nothing launched\n", n_in, out_size, ws_size); grid = -1; return; }
        int dev = 0, cus = 0, per_cu = 0;
        if (hipGetDevice(&dev) != hipSuccess || hipDeviceGetAttribute(&cus, hipDeviceAttributeMultiprocessorCount, dev) != hipSuccess) { fprintf(stderr, "kernel_launch: device query failed\n"); grid = -1; return; }
        if (hipFuncSetAttribute((const void*)mk_fwd, hipFuncAttributeMaxDynamicSharedMemorySize, LDS_BYTES) != hipSuccess) { fprintf(stderr, "kernel_launch: hipFuncSetAttribute failed\n"); grid = -1; return; }
        if (hipOccupancyMaxActiveBlocksPerMultiprocessor(&per_cu, (const void*)mk_fwd, NWAVES * 64, LDS_BYTES) != hipSuccess || per_cu < 1)
            fprintf(stderr, "kernel_launch: note: occupancy query reports %d workgroups per CU\n", per_cu);
        (void)hipGetLastError();
        grid = cus;
    }
    if (grid < 0) return;
    if (hipMemsetAsync((char*)d_ws + WS_CTL, 0, CTL_ZERO_BYTES, stream) != hipSuccess) { fprintf(stderr, "kernel_launch: memset failed\n"); return; }
    Args a{};
    for (int i = 0; i < 24; ++i) a.in[i] = (const float*)d_in[i];
    a.out = (float*)d_out; a.ws = (unsigned char*)d_ws;
    auto launch = [&](int lo, int hi) { a.ph_lo = lo; a.ph_hi = hi; hipLaunchKernelGGL(mk_fwd, dim3(grid), dim3(NWAVES * 64), LDS_BYTES, stream, a); };
#ifndef MK_ONE_LAUNCH
#define MK_ONE_LAUNCH 1
#endif
    if (MK_ONE_LAUNCH) launch(PH_PRO, PH_END);
#ifndef MK_STOP
#define MK_STOP PH_END
#endif
    else for (int ph = PH_PRO; ph < MK_STOP; ++ph) launch(ph, ph + 1);
}
```
